# Optimizing an MI355X kernel written in HIP

```python
import math
import jax, jax.numpy as jnp
from jax import lax
import numpy as np

D_MODEL = 2048
BATCH = 1
SEQ = 8192
DEPTH = 1

N_HEADS = 16
HEAD_DIM = 128
ATT_WIDTH = N_HEADS * HEAD_DIM
MOBA_BLOCK = 256
MOBA_TOPK = 3
QUERY_CHUNK = 32
LRU_WIDTH = D_MODEL
LRU_BLOCKS = 16
LRU_BLOCK_W = LRU_WIDTH // LRU_BLOCKS
CONV_WIDTH = 4
LRU_C = 8.0
D_FF = int(math.ceil(8 * D_MODEL / 3 / 256)) * 256
IN_COLS = 3 * ATT_WIDTH + 2 * LRU_WIDTH + 2 * D_MODEL
SPLIT_POINTS = (ATT_WIDTH, 2 * ATT_WIDTH, 3 * ATT_WIDTH,
                3 * ATT_WIDTH + LRU_WIDTH, 3 * ATT_WIDTH + 2 * LRU_WIDTH,
                3 * ATT_WIDTH + 2 * LRU_WIDTH + D_MODEL)
EPS = 1e-6
NEG_INF = -1e30

kernel_name = "moba_rglru_gated_hybrid"


def rms_norm(x, w):
    xf = x.astype(jnp.float32)
    y = xf * lax.rsqrt(jnp.mean(xf * xf, axis=-1, keepdims=True) + EPS)
    return (y * w.astype(jnp.float32)).astype(x.dtype)


def alibi_slopes(n_heads):
    h = jnp.arange(1, n_heads + 1, dtype=jnp.float32)
    return jnp.exp2(-8.0 * h / n_heads)


def moba_attention(q, k, v):
    B, S, H, Dh = q.shape
    n_blk = -(-S // MOBA_BLOCK)
    s_pad = n_blk * MOBA_BLOCK
    topk = min(MOBA_TOPK, n_blk)
    pad = ((0, 0), (0, s_pad - S), (0, 0), (0, 0))
    kb = jnp.pad(k, pad).reshape(B, n_blk, MOBA_BLOCK, H, Dh).transpose(0, 3, 1, 2, 4)
    vb = jnp.pad(v, pad).reshape(B, n_blk, MOBA_BLOCK, H, Dh).transpose(0, 3, 1, 2, 4)
    k_mean = jnp.mean(kb.astype(jnp.float32), axis=3).astype(q.dtype)
    slopes = alibi_slopes(H)
    scale = HEAD_DIM ** -0.5
    b_idx = jnp.arange(B)[:, None, None, None]
    h_idx = jnp.arange(H)[None, None, :, None]
    blk_offsets = jnp.arange(MOBA_BLOCK)
    n_chunks = S // QUERY_CHUNK

    def one_chunk(c):
        t0 = c * QUERY_CHUNK
        blk = t0 // MOBA_BLOCK
        qc = lax.dynamic_slice_in_dim(q, t0, QUERY_CHUNK, axis=1)
        pos_q = t0 + jnp.arange(QUERY_CHUNK)
        gate = jnp.einsum('bqhd,bhnd->bqhn', qc, k_mean).astype(jnp.float32)
        gate = jnp.where(jnp.arange(n_blk) < blk, gate, NEG_INF)
        _, sel = lax.top_k(gate, topk)
        valid = jnp.arange(topk) < blk
        k_sel = kb[b_idx, h_idx, sel]
        v_sel = vb[b_idx, h_idx, sel]
        s_sel = jnp.einsum('bqhd,bqhjsd->bqhjs', qc, k_sel).astype(jnp.float32) * scale
        key_pos = sel[..., None] * MOBA_BLOCK + blk_offsets
        dist_sel = (pos_q[None, :, None, None, None] - key_pos).astype(jnp.float32)
        s_sel = s_sel - slopes[None, None, :, None, None] * dist_sel
        s_sel = jnp.where(valid[:, None], s_sel, NEG_INF)
        k_own = lax.dynamic_index_in_dim(kb, blk, axis=2, keepdims=False)
        v_own = lax.dynamic_index_in_dim(vb, blk, axis=2, keepdims=False)
        s_own = jnp.einsum('bqhd,bhsd->bqhs', qc, k_own).astype(jnp.float32) * scale
        dist_own = pos_q[:, None] - (blk * MOBA_BLOCK + blk_offsets)[None, :]
        s_own = jnp.where(dist_own[None, :, None, :] >= 0,
                          s_own - slopes[None, None, :, None] * dist_own.astype(jnp.float32)[None, :, None, :],
                          NEG_INF)
        s_all = jnp.concatenate([s_sel.reshape(B, QUERY_CHUNK, H, topk * MOBA_BLOCK), s_own], axis=-1)
        p = jax.nn.softmax(s_all, axis=-1).astype(v.dtype)
        p_sel = p[..., :topk * MOBA_BLOCK].reshape(B, QUERY_CHUNK, H, topk, MOBA_BLOCK)
        p_own = p[..., topk * MOBA_BLOCK:]
        return (jnp.einsum('bqhjs,bqhjsd->bqhd', p_sel, v_sel)
                + jnp.einsum('bqhs,bhsd->bqhd', p_own, v_own))

    out = lax.map(one_chunk, jnp.arange(n_chunks))
    return out.transpose(1, 0, 2, 3, 4).reshape(B, S, H * Dh)


def _lru_combine(left, right):
    a_l, b_l = left
    a_r, b_r = right
    return a_l * a_r, a_r * b_l + b_r


def rglru_branch(xr, yr, conv_w, conv_b, w_rg_a, b_rg_a, w_rg_x, b_rg_x, lru_lambda):
    B, S, W = xr.shape
    xp = jnp.pad(xr, ((0, 0), (CONV_WIDTH - 1, 0), (0, 0)))
    u = conv_b
    for tap in range(CONV_WIDTH):
        u = u + xp[:, tap:tap + S] * conv_w[tap]
    ub = u.reshape(B, S, LRU_BLOCKS, LRU_BLOCK_W)
    r = jax.nn.sigmoid((jnp.einsum('bsnc,ncd->bsnd', ub, w_rg_a).reshape(B, S, W) + b_rg_a).astype(jnp.float32))
    i = jax.nn.sigmoid((jnp.einsum('bsnc,ncd->bsnd', ub, w_rg_x).reshape(B, S, W) + b_rg_x).astype(jnp.float32))
    log_a = -LRU_C * r * jax.nn.softplus(-lru_lambda.astype(jnp.float32))
    a = jnp.exp(log_a)
    mult = jnp.sqrt(-jnp.expm1(2.0 * log_a))
    bx = mult * i * u.astype(jnp.float32)
    _, h = lax.associative_scan(_lru_combine, (a, bx), axis=1)
    return h.astype(xr.dtype) * jax.nn.gelu(yr)


def hybrid_layer(x, norm1_w, w_in, q_norm_w, k_norm_w, conv_w, conv_b, w_rg_a, b_rg_a,
                 w_rg_x, b_rg_x, lru_lambda, w_proj_attn, w_proj_lru, w_out,
                 norm2_w, w_ffn_gate, w_ffn_up, w_ffn_down):
    B, S, _ = x.shape
    h = rms_norm(x, norm1_w)
    proj = h @ w_in
    q, k, v, xr, yr, g_att, g_lru = jnp.split(proj, SPLIT_POINTS, axis=-1)
    q = rms_norm(q.reshape(B, S, N_HEADS, HEAD_DIM), q_norm_w)
    k = rms_norm(k.reshape(B, S, N_HEADS, HEAD_DIM), k_norm_w)
    v = v.reshape(B, S, N_HEADS, HEAD_DIM)
    att = moba_attention(q, k, v)
    lru = rglru_branch(xr, yr, conv_w, conv_b, w_rg_a, b_rg_a, w_rg_x, b_rg_x, lru_lambda)
    merged = (jax.nn.sigmoid(g_att) * (att @ w_proj_attn)
              + jax.nn.sigmoid(g_lru) * (lru @ w_proj_lru))
    x = x + merged @ w_out
    h2 = rms_norm(x, norm2_w)
    x = x + (jax.nn.silu(h2 @ w_ffn_gate) * (h2 @ w_ffn_up)) @ w_ffn_down
    return x


def setup_inputs(seed: int = 0) -> dict:
    key = jax.random.key(seed)
    ks = jax.random.split(key, 20)
    L = DEPTH
    nrm = lambda k, shape, fan_in: jax.random.normal(k, shape, jnp.float32) * fan_in ** -0.5
    u = jax.random.uniform(ks[11], (L, LRU_WIDTH), jnp.float32, minval=0.9, maxval=0.999)
    a0 = u ** (1.0 / LRU_C)
    lam = jnp.log(a0) - jnp.log1p(-a0)
    return {
        "x": jax.random.normal(ks[0], (BATCH, SEQ, D_MODEL), jnp.float32),
        "norm1_w": 1.0 + 0.05 * jax.random.normal(ks[1], (L, D_MODEL), jnp.float32),
        "w_in": nrm(ks[2], (L, D_MODEL, IN_COLS), D_MODEL),
        "q_norm_w": 1.0 + 0.05 * jax.random.normal(ks[3], (L, HEAD_DIM), jnp.float32),
        "k_norm_w": 1.0 + 0.05 * jax.random.normal(ks[4], (L, HEAD_DIM), jnp.float32),
        "conv_w": nrm(ks[5], (L, CONV_WIDTH, LRU_WIDTH), CONV_WIDTH),
        "conv_b": 0.01 * jax.random.normal(ks[6], (L, LRU_WIDTH), jnp.float32),
        "w_rg_a": nrm(ks[7], (L, LRU_BLOCKS, LRU_BLOCK_W, LRU_BLOCK_W), LRU_BLOCK_W),
        "b_rg_a": 0.01 * jax.random.normal(ks[8], (L, LRU_WIDTH), jnp.float32),
        "w_rg_x": nrm(ks[9], (L, LRU_BLOCKS, LRU_BLOCK_W, LRU_BLOCK_W), LRU_BLOCK_W),
        "b_rg_x": 0.01 * jax.random.normal(ks[10], (L, LRU_WIDTH), jnp.float32),
        "lru_lambda": lam,
        "w_proj_attn": nrm(ks[12], (L, ATT_WIDTH, D_MODEL), ATT_WIDTH),
        "w_proj_lru": nrm(ks[13], (L, LRU_WIDTH, D_MODEL), LRU_WIDTH),
        "w_out": nrm(ks[14], (L, D_MODEL, D_MODEL), D_MODEL),
        "norm2_w": 1.0 + 0.05 * jax.random.normal(ks[15], (L, D_MODEL), jnp.float32),
        "w_ffn_gate": nrm(ks[16], (L, D_MODEL, D_FF), D_MODEL),
        "w_ffn_up": nrm(ks[17], (L, D_MODEL, D_FF), D_MODEL),
        "w_ffn_down": nrm(ks[18], (L, D_FF, D_MODEL), D_FF),
    }


def reference(x, norm1_w, w_in, q_norm_w, k_norm_w, conv_w, conv_b, w_rg_a, b_rg_a,
              w_rg_x, b_rg_x, lru_lambda, w_proj_attn, w_proj_lru, w_out,
              norm2_w, w_ffn_gate, w_ffn_up, w_ffn_down):
    for layer in range(DEPTH):
        x = hybrid_layer(x, norm1_w[layer], w_in[layer], q_norm_w[layer], k_norm_w[layer],
                         conv_w[layer], conv_b[layer], w_rg_a[layer], b_rg_a[layer],
                         w_rg_x[layer], b_rg_x[layer], lru_lambda[layer],
                         w_proj_attn[layer], w_proj_lru[layer], w_out[layer],
                         norm2_w[layer], w_ffn_gate[layer], w_ffn_up[layer], w_ffn_down[layer])
    return x
```

```cpp
#include <hip/hip_runtime.h>
#include <cstdio>
#include <cstdint>
#ifndef PROBE_VAR
#define PROBE_VAR 0
#endif
#ifndef PROBE_REP
#define PROBE_REP -1
#endif

constexpr int S = 8192, DM = 2048, NH = 16, HD = 128, NBLK = 32, BLK = 256;
constexpr int DFF = 5632, INC = 14336;
constexpr int CQ = 0, CK = 2048, CV = 4096, CXR = 6144, CYR = 8192, CGA = 10240, CGL = 12288;
constexpr float EPS = 1e-6f;
constexpr float ATT_SCALE = 0.08838834764831845f;
constexpr float QSCALE_ = ATT_SCALE * 1.4426950408889634f;

constexpr size_t MiB = 1u << 20;
constexpr size_t WS_CTL = 0, CTL_ZERO_BYTES = 1 * MiB;
constexpr size_t WS_RSTD1 = 1 * MiB;
constexpr size_t WS_KMEAN = 1 * MiB + 64 * 1024;
constexpr size_t WS_CNT = 1 * MiB + 384 * 1024;
constexpr size_t WS_LAGG = 1 * MiB + 512 * 1024;
constexpr size_t WS_SELJ = 2 * MiB;
constexpr size_t WS_SSQ = 3 * MiB;
constexpr size_t WS_WRG = 4 * MiB;
constexpr size_t WS_WP = 5 * MiB;
constexpr size_t WS_WO = 21 * MiB;
constexpr size_t WS_WIN = 29 * MiB;
constexpr size_t WS_LIST = 29 * MiB;
constexpr size_t WS_ML = 37 * MiB;
constexpr size_t WS_AL = 40 * MiB;
constexpr size_t WS_XB = 85 * MiB;
constexpr size_t WS_P = 117 * MiB;
constexpr size_t WS_WGU = 117 * MiB;
constexpr size_t WS_WD = 161 * MiB;
constexpr size_t WS_X1B = 183 * MiB;
constexpr size_t WS_ACT = 215 * MiB;
constexpr size_t WS_PO = 341 * MiB;
constexpr size_t WS_LX2 = WS_AL;
constexpr size_t WS_LBX = WS_AL + 2048 * 2;
constexpr size_t WS_MRG = 341 * MiB;
constexpr size_t WS_END = 437 * MiB;

#define GAS __attribute__((address_space(1)))
#define LAS __attribute__((address_space(3)))
typedef unsigned short bf16;
typedef unsigned v4u __attribute__((ext_vector_type(4)));
typedef unsigned v2u __attribute__((ext_vector_type(2)));
typedef float f32x4 __attribute__((ext_vector_type(4)));
__device__ __forceinline__ unsigned f2bf(float f) { unsigned u = __builtin_bit_cast(unsigned, f); return (u + 0x7fffu + ((u >> 16) & 1u)) >> 16; }
__device__ __forceinline__ unsigned pk2(float lo, float hi) { return f2bf(lo) | (f2bf(hi) << 16); }
__device__ __forceinline__ float bf2f(unsigned b) { return __builtin_bit_cast(float, b << 16); }
__device__ __forceinline__ float bflo(unsigned u) { return __builtin_bit_cast(float, u << 16); }
__device__ __forceinline__ float bfhi(unsigned u) { return __builtin_bit_cast(float, u & 0xffff0000u); }
__device__ __forceinline__ float wave_sum(float v) {
#pragma unroll
    for (int o = 1; o < 64; o <<= 1) v += __shfl_xor(v, o);
    return v;
}
__device__ __forceinline__ float sigmoidf_(float x) { return 1.f / (1.f + __expf(-x)); }
__device__ __forceinline__ float gelu_tanh(float x) { const float u = 0.7978845608028654f * (x + 0.044715f * x * x * x); return 0.5f * x * (1.f + tanhf(u)); }

constexpr int NWAVES = 8, NTHR = 512;
constexpr int LDS_BYTES = 163840;

struct Args { const float* in[19]; float* out; unsigned char* ws; int ph_lo, ph_hi, var, pad; };
enum { I_X = 0, I_N1W, I_WIN, I_QNW, I_KNW, I_CONVW, I_CONVB, I_WRGA, I_BRGA, I_WRGX, I_BRGX, I_LAM, I_WPA, I_WPL, I_WOUT, I_N2W, I_WG, I_WU, I_WD };

typedef short s16x4_ __attribute__((ext_vector_type(4)));
__device__ __forceinline__ void tr_item(const float* W, int ldw, int k0, int n0, const float* kscale, bf16* WT, size_t drow0, int ldt, int dcol0, LAS unsigned char* scr, int lane) {
    const int kr = lane >> 4, nq = lane & 15;
    f32x4 v[16];
#pragma unroll
    for (int i = 0; i < 16; ++i) v[i] = *(const f32x4*)(W + (size_t)(k0 + 4 * i + kr) * ldw + n0 + 4 * nq);
    if (kscale) {
#pragma unroll
        for (int i = 0; i < 16; ++i) v[i] = v[i] * kscale[k0 + 4 * i + kr]; }
#pragma unroll
    for (int i = 0; i < 16; ++i) { v2u w; w.x = pk2(v[i].x, v[i].y); w.y = pk2(v[i].z, v[i].w); *(LAS v2u*)(scr + (4 * i + kr) * 128 + 8 * nq) = w; }
    asm volatile("s_waitcnt lgkmcnt(0)" ::: "memory");
    const int g = lane >> 4, q = (lane >> 2) & 3, p = lane & 3;
    const LAS unsigned char* rb = scr + q * 128 + (16 * g + 4 * p) * 2;
    s16x4_ t[16];
#pragma unroll
    for (int kk = 0; kk < 16; ++kk) t[kk] = __builtin_bit_cast(s16x4_, __builtin_amdgcn_ds_read_tr16_b64_v4i16((LAS s16x4_*)(rb + kk * 512)));
    asm volatile("s_waitcnt lgkmcnt(0)" ::: "memory");
    const int nrow = 16 * g + (lane & 15);
#pragma unroll
    for (int e = 0; e < 8; ++e) { const v2u a = __builtin_bit_cast(v2u, t[2 * e]), b = __builtin_bit_cast(v2u, t[2 * e + 1]); v4u o = {a.x, a.y, b.x, b.y};
        *(LAS v4u*)(scr + nrow * 128 + ((e ^ (nrow & 7)) << 4)) = o; }
    asm volatile("s_waitcnt lgkmcnt(0)" ::: "memory");
    const int rr = lane >> 3, cc = lane & 7;
#pragma unroll
    for (int i = 0; i < 8; ++i) { const int r = rr + 8 * i; const v4u o = *(const LAS v4u*)(scr + r * 128 + ((cc ^ (r & 7)) << 4));
        *(v4u*)(WT + (drow0 + r) * (size_t)ldt + dcol0 + k0 + 8 * cc) = o; }
    asm volatile("s_waitcnt lgkmcnt(0)" ::: "memory");
}

struct Ctx {
    LAS unsigned char* lds; int tid, lane, wave, vcu, G, var;
    const float* const* in; float* out; unsigned char* ws;
};

__device__ __forceinline__ void phase_prepA(const Ctx& C) {
    LAS unsigned char* scr = C.lds + C.wave * 16384;
    const int gw = C.vcu * NWAVES + C.wave, NGW = C.G * NWAVES;
    constexpr int I_IN = (DM / 64) * (INC / 64), I_SQ = (DM / 64) * (DM / 64), I_RG = 32 * 4;
    constexpr int NIT = I_IN + 3 * I_SQ + I_RG;
    bf16* WIN = (bf16*)(C.ws + WS_WIN); bf16* WP = (bf16*)(C.ws + WS_WP); bf16* WO = (bf16*)(C.ws + WS_WO); bf16* WRG = (bf16*)(C.ws + WS_WRG);
    for (int it = gw; it < NIT; it += NGW) {
        int r = it;
        if (r < I_IN) { const int nb = INC / 64, kb = r / nb, n0 = (r % nb) * 64; tr_item(C.in[I_WIN], INC, kb * 64, n0, C.in[I_N1W], WIN, (size_t)n0, DM, 0, scr, C.lane); continue; } r -= I_IN;
        if (r < I_SQ) { const int nb = DM / 64, kb = r / nb, n0 = (r % nb) * 64; tr_item(C.in[I_WPA], DM, kb * 64, n0, nullptr, WP, (size_t)n0, 2 * DM, 0, scr, C.lane); continue; } r -= I_SQ;
        if (r < I_SQ) { const int nb = DM / 64, kb = r / nb, n0 = (r % nb) * 64; tr_item(C.in[I_WPL], DM, kb * 64, n0, nullptr, WP, (size_t)n0, 2 * DM, DM, scr, C.lane); continue; } r -= I_SQ;
        if (r < I_SQ) { const int nb = DM / 64, kb = r / nb, n0 = (r % nb) * 64; tr_item(C.in[I_WOUT], DM, kb * 64, n0, nullptr, WO, (size_t)n0, DM, 0, scr, C.lane); continue; } r -= I_SQ;
        { const int mat = r >> 2, sub = r & 3, n = mat >> 1, g = mat & 1, k0 = (sub >> 1) * 64, n0 = (sub & 1) * 64;
          const float* W = (g ? C.in[I_WRGX] : C.in[I_WRGA]) + (size_t)n * 128 * 128;
          tr_item(W, 128, k0, n0, nullptr, WRG, (size_t)((n * 2 + g) * 128 + n0), 128, 0, scr, C.lane); }
    }
    bf16* XB = (bf16*)(C.ws + WS_XB); float* RSTD1 = (float*)(C.ws + WS_RSTD1);
    for (int m = gw; m < S; m += NGW) {
        const f32x4* xr = (const f32x4*)(C.in[I_X] + (size_t)m * DM) + C.lane;
        f32x4 v[8]; float s = 0.f;
#pragma unroll
        for (int j = 0; j < 8; ++j) { v[j] = xr[64 * j]; s += (v[j].x * v[j].x + v[j].y * v[j].y) + (v[j].z * v[j].z + v[j].w * v[j].w); }
        s = wave_sum(s);
        if (C.lane == 0) RSTD1[m] = 1.0f / sqrtf(s * (1.f / DM) + EPS);
        v2u* o = (v2u*)(XB + (size_t)m * DM) + C.lane;
#pragma unroll
        for (int j = 0; j < 8; ++j) { v2u w; w.x = pk2(v[j].x, v[j].y); w.y = pk2(v[j].z, v[j].w); o[64 * j] = w; }
    }
}

__device__ __forceinline__ void phase_prepB_gu(const Ctx& C) {
    LAS unsigned char* scr = C.lds + C.wave * 16384;
    const int gw = C.vcu * NWAVES + C.wave, NGW = C.G * NWAVES;
    constexpr int I_GU = (DM / 64) * (DFF / 64);
    bf16* WGU = (bf16*)(C.ws + WS_WGU);
    for (int it = gw; it < 2 * I_GU; it += NGW) {
        int r = it; const int up = r >= I_GU; if (up) r -= I_GU; const int nb = DFF / 64, kb = r / nb, n0 = (r % nb) * 64;
        const size_t drow = (size_t)(n0 >> 7) * 256 + (n0 & 127) + (up ? 128 : 0);
        tr_item(up ? C.in[I_WU] : C.in[I_WG], DFF, kb * 64, n0, C.in[I_N2W], WGU, drow, DM, 0, scr, C.lane);
    }
}
__device__ __forceinline__ void phase_prepB_d(const Ctx& C, int rank, int nranks) {
    LAS unsigned char* scr = C.lds + C.wave * 16384;
    constexpr int I_D = (DFF / 64) * (DM / 64);
    bf16* WD = (bf16*)(C.ws + WS_WD);
    for (int it = rank * NWAVES + C.wave; it < I_D; it += nranks * NWAVES) { const int nb = DM / 64, kb = it / nb, n0 = (it % nb) * 64; tr_item(C.in[I_WD], DM, kb * 64, n0, nullptr, WD, (size_t)n0, DFF, 0, scr, C.lane); }
}

__device__ __forceinline__ float att_qkb(const float* qw, const float* kw, int lane) {
    float a = fmaxf(fabsf(qw[lane]), fabsf(qw[lane + 64])), b = fmaxf(fabsf(kw[lane]), fabsf(kw[lane + 64]));
#pragma unroll
    for (int o_ = 1; o_ < 64; o_ <<= 1) { a = fmaxf(a, __shfl_xor(a, o_)); b = fmaxf(b, __shfl_xor(b, o_)); }
    return 128.f * a * b * QSCALE_;
}
__device__ __forceinline__ bool att_live(int h, int m, float qkb) {
    const float sl2 = exp2f(-0.5f * (float)(h + 1)) * 1.4426950408889634f;
    return sl2 * (float)(256 * (m - 1) + 1) < qkb * 1.02f + 152.f;
}

__device__ __forceinline__ void phase_select(const Ctx& C) {
    typedef short bf16x8_ __attribute__((ext_vector_type(8))); typedef float f32x16_ __attribute__((ext_vector_type(16)));
    const bf16* P = (const bf16*)(C.ws + WS_P); const float* KMEAN = (const float*)(C.ws + WS_KMEAN);
    int* SELJ = (int*)(C.ws + WS_SELJ); int* CNT = (int*)(C.ws + WS_CNT); unsigned short* LIST = (unsigned short*)(C.ws + WS_LIST);
    LAS float* gt = (LAS float*)(C.lds + 16384);
    LAS int* wc = (LAS int*)(C.lds + 16384 + 33792);
    const float qkb = att_qkb(C.in[I_QNW], C.in[I_KNW], C.lane);
    const int r32 = C.lane & 31, hi = C.lane >> 5;
#define SEL_HB(it, H_, B_) const int H_ = (it) & 15; const int B_ = ((it) >> 4) < 16 ? ((it) >> 4) : 47 - ((it) >> 4)
    bf16x8_ qf[8];
    if (C.vcu < NH * NBLK) { SEL_HB(C.vcu, h_, b_); const bf16* qrow = P + (size_t)(b_ * BLK + C.wave * 32 + r32) * INC + CQ + h_ * HD + hi * 8;
#pragma unroll
        for (int ks = 0; ks < 8; ++ks) qf[ks] = *(const bf16x8_*)(qrow + ks * 16); }
    for (int item = C.vcu; item < NH * NBLK; item += C.G) {
        SEL_HB(item, h, b);
        const int i = C.wave * 32 + r32, t = b * BLK + i;
        {
            f32x16_ acc = {};
            const float* krow = KMEAN + (size_t)(h * NBLK + r32) * HD + hi * 8;
#pragma unroll
            for (int ks = 0; ks < 8; ++ks) {
                const f32x4 k0 = *(const f32x4*)(krow + ks * 16), k1 = *(const f32x4*)(krow + ks * 16 + 4);
                const float kv[8] = {k0[0], k0[1], k0[2], k0[3], k1[0], k1[1], k1[2], k1[3]};
                unsigned hw[4], lw[4];
#pragma unroll
                for (int e = 0; e < 4; ++e) { const unsigned h0 = f2bf(kv[2 * e]), h1 = f2bf(kv[2 * e + 1]); hw[e] = h0 | (h1 << 16);
                    lw[e] = pk2(kv[2 * e] - bf2f(h0), kv[2 * e + 1] - bf2f(h1)); }
                const v4u hv = {hw[0], hw[1], hw[2], hw[3]}, lv = {lw[0], lw[1], lw[2], lw[3]};
                acc = __builtin_amdgcn_mfma_f32_32x32x16_bf16(qf[ks], __builtin_bit_cast(bf16x8_, hv), acc, 0, 0, 0);
                acc = __builtin_amdgcn_mfma_f32_32x32x16_bf16(qf[ks], __builtin_bit_cast(bf16x8_, lv), acc, 0, 0, 0); }
#pragma unroll
            for (int r = 0; r < 16; ++r) gt[(C.wave * 32 + (r & 3) + 8 * (r >> 2) + 4 * hi) * 33 + r32] = acc[r];
        }
        if (item + C.G < NH * NBLK) { SEL_HB(item + C.G, h_, b_); const bf16* qrow = P + (size_t)(b_ * BLK + C.wave * 32 + r32) * INC + CQ + h_ * HD + hi * 8;
#pragma unroll
            for (int ks = 0; ks < 8; ++ks) qf[ks] = *(const bf16x8_*)(qrow + ks * 16); }
        __syncthreads();
        const int bh = (b + 1) >> 1, jlo = hi ? bh : 0, jhi = hi ? b : bh;
        int j0 = 255, j1 = 255, j2 = 255;
        { float v0 = -INFINITY, v1 = -INFINITY, v2 = -INFINITY;
          for (int j = jlo; j < jhi; ++j) { const float g = gt[i * 33 + j];
              if (g > v0) { v2 = v1; j2 = j1; v1 = v0; j1 = j0; v0 = g; j0 = j; }
              else if (g > v1) { v2 = v1; j2 = j1; v1 = g; j1 = j; }
              else if (g > v2) { v2 = g; j2 = j; } }
#define SWP(x, A_, B_) { const auto rr_ = __builtin_amdgcn_permlane32_swap(__float_as_uint(x), __float_as_uint(x), false, false); A_ = __uint_as_float(rr_[0]); B_ = __uint_as_float(rr_[1]); }
#define SWPI(x, A_, B_) { const auto rr_ = __builtin_amdgcn_permlane32_swap((unsigned)(x), (unsigned)(x), false, false); A_ = (int)rr_[0]; B_ = (int)rr_[1]; }
          float a0, a1, a2, b0, b1, b2; int ja0, ja1, ja2, jb0, jb1, jb2;
          SWP(v0, a0, b0); SWP(v1, a1, b1); SWP(v2, a2, b2); SWPI(j0, ja0, jb0); SWPI(j1, ja1, jb1); SWPI(j2, ja2, jb2);
#undef SWP
#undef SWPI
          bool ta = a0 >= b0; j0 = ta ? ja0 : jb0;
          { const float na0 = ta ? a1 : a0, na1 = ta ? a2 : a1; const int nja0 = ta ? ja1 : ja0, nja1 = ta ? ja2 : ja1;
            const float nb0 = ta ? b0 : b1, nb1 = ta ? b1 : b2; const int njb0 = ta ? jb0 : jb1, njb1 = ta ? jb1 : jb2;
            const bool tb = na0 >= nb0; j1 = tb ? nja0 : njb0;
            const float ma0 = tb ? na1 : na0, mb0 = tb ? nb0 : nb1; const int mja0 = tb ? nja1 : nja0, mjb0 = tb ? njb0 : njb1;
            j2 = (ma0 >= mb0) ? mja0 : mjb0; } }
        if (hi == 0) SELJ[t * NH + h] = j0 | (j1 << 8) | (j2 << 16);
        for (int jj = 0; jj < bh; ++jj) { const int j = jj + jlo; const bool hit = j < b && ((j0 == j) | (j1 == j) | (j2 == j)) && att_live(h, b - j, qkb);
            const unsigned long long bal = __ballot(hit); if (C.lane == 0) { wc[jj * 16 + C.wave * 2] = __popc((unsigned)bal); wc[jj * 16 + C.wave * 2 + 1] = __popc((unsigned)(bal >> 32)); } }
        __syncthreads();
        for (int jj = 0; jj < bh; ++jj) { const int j = jj + jlo; const bool hit = j < b && ((j0 == j) | (j1 == j) | (j2 == j)) && att_live(h, b - j, qkb);
            const unsigned long long bal = __ballot(hit); const unsigned mine = hi ? (unsigned)(bal >> 32) : (unsigned)bal;
            int off = 0;
#pragma unroll
            for (int wv = 0; wv < 8; ++wv) off += (wv < C.wave) ? wc[jj * 16 + wv * 2 + hi] : 0;
            off += __popc(mine & ((1u << r32) - 1u));
            const int slot = (j0 == j) ? 0 : (j1 == j) ? 1 : 2;
            if (hit) LIST[((size_t)(h * NBLK + j) * NBLK + b) * BLK + off] = (unsigned short)(i | (slot << 8)); }
        if (C.tid < b) { const int j = C.tid, hf = j >= bh, jj = j - (hf ? bh : 0); int nsum = 0;
#pragma unroll
            for (int wv = 0; wv < 8; ++wv) nsum += wc[jj * 16 + wv * 2 + hf];
            CNT[(h * NBLK + j) * NBLK + b] = nsum; }
        __syncthreads();
    }
#undef SEL_HB
}

#define LSWZ(row, colB) ((row) * 256 + ((colB) ^ (((row) & 7) << 4)))
typedef float f32x2_ __attribute__((ext_vector_type(2)));
__device__ __forceinline__ unsigned cvt_pk_bf16_(float lo, float hi) { unsigned r; asm volatile("v_cvt_pk_bf16_f32 %0, %1, %2" : "=v"(r) : "v"(lo), "v"(hi)); return r; }
__device__ __forceinline__ f32x2_ bfpair(unsigned w) { f32x2_ r; r.x = bflo(w); r.y = bfhi(w); return r; }
__device__ __forceinline__ f32x2_ exp2_2(f32x2_ v) { f32x2_ r; r.x = __builtin_amdgcn_exp2f(v.x); r.y = __builtin_amdgcn_exp2f(v.y); return r; }
__device__ __forceinline__ f32x2_ rcp_2(f32x2_ v) { f32x2_ r; r.x = __builtin_amdgcn_rcpf(v.x); r.y = __builtin_amdgcn_rcpf(v.y); return r; }
template <int MODE> __device__ __forceinline__ void phase_lru(const Ctx& C) {
    typedef short bf16x8_ __attribute__((ext_vector_type(8))); typedef float f32x16_ __attribute__((ext_vector_type(16)));
    const bf16* P = (const bf16*)(C.ws + WS_P); bf16* AL = (bf16*)(C.ws + WS_AL); float* LAGG = (float*)(C.ws + WS_LAGG); const bf16* WRG = (const bf16*)(C.ws + WS_WRG);
    bf16* LX2 = (bf16*)(C.ws + WS_LX2); bf16* LBX = (bf16*)(C.ws + WS_LBX);
    LAS unsigned char* Ub = C.lds;
    LAS float* A = (LAS float*)(C.lds + 16384);
    LAS float* BX = (LAS float*)(C.lds + 49152);
    LAS unsigned char* G = C.lds + 81920;
    LAS unsigned char* OUTI = C.lds + 98304;
    LAS f32x4* SEG = (LAS f32x4*)(C.lds + 114688);
    LAS unsigned char* XR = C.lds + 122880;
    LAS unsigned char* YR = C.lds + 122880 + 17152;
    const int lane = C.lane, r32 = lane & 31, hi = lane >> 5, th = C.wave >> 2, db = C.wave & 3;
    const int cp = lane, sg = C.wave;
    constexpr float L2E = 1.4426950408889634f;
    for (int item = C.vcu; item < 256; item += C.G) {
        const int n = item & 15, c = item >> 4, ch0 = n * 128, t0 = c * 512;
        f32x2_ cw0, cw1, cw2, cw3, cb;
        { const float* w = C.in[I_CONVW] + ch0 + 2 * cp; cw0 = *(const f32x2_*)w; cw1 = *(const f32x2_*)(w + DM); cw2 = *(const f32x2_*)(w + 2 * DM); cw3 = *(const f32x2_*)(w + 3 * DM); cb = *(const f32x2_*)(C.in[I_CONVB] + ch0 + 2 * cp); }
        const int dcol = db * 32 + r32;
        const float ba = C.in[I_BRGA][ch0 + dcol], bxb = C.in[I_BRGX][ch0 + dcol];
        const float sp8 = 8.0f * log1pf(__expf(-C.in[I_LAM][ch0 + dcol]));
        bf16x8_ wa[8], wx[8];
#pragma unroll
        for (int ks = 0; ks < 8; ++ks) { wa[ks] = *(const bf16x8_*)(WRG + (size_t)((n * 2 + 0) * 128 + dcol) * 128 + ks * 16 + hi * 8);
                                         wx[ks] = *(const bf16x8_*)(WRG + (size_t)((n * 2 + 1) * 128 + dcol) * 128 + ks * 16 + hi * 8); }
        f32x2_ hst = {0.f, 0.f}, aprod = {1.f, 1.f};
        if (MODE == 1) { for (int cc = 0; cc < c; ++cc) { const f32x4 ag = *(const f32x4*)(LAGG + (size_t)(cc * 2048 + ch0 + 2 * cp) * 2); hst.x = ag[0] * hst.x + ag[1]; hst.y = ag[2] * hst.y + ag[3]; } }
#define LBAR() do { asm volatile("s_waitcnt lgkmcnt(0)" ::: "memory"); __builtin_amdgcn_s_barrier(); asm volatile("" ::: "memory"); } while (0)
#define LRU_DMA(tsub) do { \
            for (int r_ = C.wave; r_ < 67; r_ += 8) { int tt_ = (tsub) - 3 + r_; if (tt_ < 0) tt_ = 0; \
                __builtin_amdgcn_global_load_lds((const unsigned*)(P + (size_t)tt_ * INC + CXR + ch0 + 2 * lane), (LAS unsigned*)(XR + r_ * 256), 4, 0, 0); } \
            if (MODE == 1) { for (int r_ = C.wave; r_ < 64; r_ += 8) \
                __builtin_amdgcn_global_load_lds((const unsigned*)(P + (size_t)((tsub) + r_) * INC + CYR + ch0 + 2 * lane), (LAS unsigned*)(YR + r_ * 256), 4, 0, 0); } } while (0)
        LRU_DMA(t0);
        asm volatile("s_waitcnt vmcnt(0)" ::: "memory"); LBAR();
        for (int sc = 0; sc < 8; ++sc) {
            const int ts = t0 + sc * 64;
            { f32x2_ x0 = bfpair(*(const LAS unsigned*)(XR + (sg * 8 + 0) * 256 + 4 * cp)), x1 = bfpair(*(const LAS unsigned*)(XR + (sg * 8 + 1) * 256 + 4 * cp)), x2_ = bfpair(*(const LAS unsigned*)(XR + (sg * 8 + 2) * 256 + 4 * cp));
              if (ts + sg * 8 == 0) { x0 = (f32x2_){0.f, 0.f}; x1 = x0; x2_ = x0; }
#pragma unroll
              for (int k = 0; k < 8; ++k) { const int tr = sg * 8 + k; const f32x2_ x3 = bfpair(*(const LAS unsigned*)(XR + (tr + 3) * 256 + 4 * cp));
                  const f32x2_ uu = cb + cw0 * x0 + cw1 * x1 + cw2 * x2_ + cw3 * x3; x0 = x1; x1 = x2_; x2_ = x3;
                  *(LAS unsigned*)(Ub + LSWZ(tr, 4 * cp)) = cvt_pk_bf16_(uu.x, uu.y);
                  if (MODE == 1) { const f32x2_ y = bfpair(*(const LAS unsigned*)(YR + tr * 256 + 4 * cp));
                      const f32x2_ e2 = exp2_2((y + (y * y) * y * 0.044715f) * (-1.5957691216057308f * L2E));
                      const f32x2_ gy = y * rcp_2(e2 + 1.f); *(LAS unsigned*)(G + tr * 256 + 4 * cp) = cvt_pk_bf16_(gy.x, gy.y); } } }
            LBAR();
            if (sc < 7) LRU_DMA(ts + 64);
            if (MODE == 1 && sc > 0) {
#pragma unroll
                for (int i = 0; i < 2; ++i) { const int pc = C.tid + i * NTHR, tr = pc >> 4, cq = pc & 15;
                    *(v4u*)(AL + (size_t)(ts - 64 + tr) * 4096 + 2048 + ch0 + cq * 8) = *(const LAS v4u*)(OUTI + tr * 256 + cq * 16); } }
            { f32x16_ accA = {}, accX = {};
#pragma unroll
              for (int ks = 0; ks < 8; ++ks) { const bf16x8_ af = *(const LAS bf16x8_*)(Ub + LSWZ(th * 32 + r32, (ks * 16 + hi * 8) * 2));
                  accA = __builtin_amdgcn_mfma_f32_32x32x16_bf16(af, wa[ks], accA, 0, 0, 0); accX = __builtin_amdgcn_mfma_f32_32x32x16_bf16(af, wx[ks], accX, 0, 0, 0); }
              f32x2_ x2v[8]; bool slow = false;
#pragma unroll
              for (int rp = 0; rp < 8; ++rp) { const f32x2_ za = ((f32x2_){accA[2 * rp], accA[2 * rp + 1]} + ba) * (-L2E);
                  x2v[rp] = rcp_2(exp2_2(za) + 1.f) * (-2.0f * sp8); slow |= (x2v[rp].x <= -0.25f) | (x2v[rp].y <= -0.25f); }
              const bool anyslow = __any(slow);
#pragma unroll
              for (int rp = 0; rp < 8; ++rp) { const int r = 2 * rp; const int tr = th * 32 + (r & 3) + 8 * (r >> 2) + 4 * hi;
                  f32x2_ u; u.x = bf2f(*(const LAS unsigned short*)(Ub + LSWZ(tr, 2 * dcol))); u.y = bf2f(*(const LAS unsigned short*)(Ub + LSWZ(tr + 1, 2 * dcol)));
                  const f32x2_ zi = ((f32x2_){accX[r], accX[r + 1]} + bxb) * (-L2E); const f32x2_ ig = rcp_2(exp2_2(zi) + 1.f);
                  const f32x2_ x2 = x2v[rp]; const f32x2_ a = exp2_2(x2 * (0.5f * L2E));
                  f32x2_ om = -x2 * (x2 * (x2 * (x2 * (x2 * 0.008333334f + 0.041666668f) + 0.16666667f) + 0.5f) + 1.f);
                  if (anyslow) { const f32x2_ ex = exp2_2(x2 * L2E); om.x = (x2.x > -0.25f) ? om.x : 1.f - ex.x; om.y = (x2.y > -0.25f) ? om.y : 1.f - ex.y; }
                  f32x2_ sq; sq.x = __builtin_amdgcn_sqrtf(om.x); sq.y = __builtin_amdgcn_sqrtf(om.y);
                  const f32x2_ bx = sq * ig * u;
                  A[tr * 128 + dcol] = a.x; A[(tr + 1) * 128 + dcol] = a.y; BX[tr * 128 + dcol] = bx.x; BX[(tr + 1) * 128 + dcol] = bx.y;
                  if (MODE == 0) { *(LAS unsigned short*)(G + tr * 256 + 2 * dcol) = (unsigned short)(cvt_pk_bf16_(x2.x, 0.f)); *(LAS unsigned short*)(G + (tr + 1) * 256 + 2 * dcol) = (unsigned short)(cvt_pk_bf16_(x2.y, 0.f));
                                   *(LAS unsigned short*)(OUTI + tr * 256 + 2 * dcol) = (unsigned short)(cvt_pk_bf16_(bx.x, 0.f)); *(LAS unsigned short*)(OUTI + (tr + 1) * 256 + 2 * dcol) = (unsigned short)(cvt_pk_bf16_(bx.y, 0.f)); } } }
            LBAR();
            if (MODE == 0) {
#pragma unroll
                for (int i = 0; i < 2; ++i) { const int pc = C.tid + i * NTHR, tr = pc >> 4, cq = pc & 15; const size_t go = (size_t)(ts + tr) * 4096 + ch0 + cq * 8;
                    *(v4u*)(LX2 + go) = *(const LAS v4u*)(G + tr * 256 + cq * 16); *(v4u*)(LBX + go) = *(const LAS v4u*)(OUTI + tr * 256 + cq * 16); } }
            { f32x2_ ap = {1.f, 1.f}, hl = {0.f, 0.f};
#pragma unroll
              for (int k = 0; k < 8; ++k) { const f32x2_ a = *(const LAS f32x2_*)(A + (sg * 8 + k) * 128 + 2 * cp); hl = a * hl + *(const LAS f32x2_*)(BX + (sg * 8 + k) * 128 + 2 * cp); ap = ap * a; }
              SEG[sg * 64 + cp] = (f32x4){ap.x, ap.y, hl.x, hl.y}; }
            LBAR();
            { f32x2_ hin = hst, hrun = hst, arun = {1.f, 1.f};
#pragma unroll
              for (int s = 0; s < 8; ++s) { const f32x4 sv = SEG[s * 64 + cp]; const f32x2_ as_ = {sv[0], sv[1]}, hs_ = {sv[2], sv[3]}; if (s == sg) hin = hrun; hrun = as_ * hrun + hs_; arun = arun * as_; }
              hst = hrun; aprod = aprod * arun;
              if (MODE == 1) {
#pragma unroll
                  for (int k = 0; k < 8; ++k) { const int tr = sg * 8 + k; hin = *(const LAS f32x2_*)(A + tr * 128 + 2 * cp) * hin + *(const LAS f32x2_*)(BX + tr * 128 + 2 * cp);
                      const f32x2_ yv = hin * bfpair(*(const LAS unsigned*)(G + tr * 256 + 4 * cp));
                      *(LAS unsigned*)(OUTI + tr * 256 + 4 * cp) = cvt_pk_bf16_(yv.x, yv.y); } } }
            asm volatile("s_waitcnt vmcnt(0)" ::: "memory"); LBAR();
        }
        if (MODE == 1) {
#pragma unroll
            for (int i = 0; i < 2; ++i) { const int pc = C.tid + i * NTHR, tr = pc >> 4, cq = pc & 15;
                *(v4u*)(AL + (size_t)(t0 + 448 + tr) * 4096 + 2048 + ch0 + cq * 8) = *(const LAS v4u*)(OUTI + tr * 256 + cq * 16); }
            asm volatile("s_waitcnt lgkmcnt(0)" ::: "memory"); __builtin_amdgcn_s_barrier();
        }
        if (MODE == 0 && sg == 0) *(f32x4*)(LAGG + (size_t)(c * 2048 + ch0 + 2 * cp) * 2) = (f32x4){aprod.x, hst.x, aprod.y, hst.y};
    }
#undef LRU_DMA
#undef LBAR
}

__device__ __forceinline__ void phase_lru_a(const Ctx& C) {
    typedef short bf16x8_ __attribute__((ext_vector_type(8))); typedef float f32x16_ __attribute__((ext_vector_type(16)));
    const bf16* P = (const bf16*)(C.ws + WS_P); float* LAGG = (float*)(C.ws + WS_LAGG); const bf16* WRG = (const bf16*)(C.ws + WS_WRG);
    bf16* LX2 = (bf16*)(C.ws + WS_LX2); bf16* LBX = (bf16*)(C.ws + WS_LBX);
    constexpr int O_UB = 0, O_G = 32768, O_OI = 65536, O_XR = 98304, XRB = 17152, O_AGG = O_XR + 2 * XRB;
    static_assert(O_AGG + 16384 <= 163584, "LRU-A LDS map");
    const int lane = C.lane, r32 = lane & 31, hi = lane >> 5, th = C.wave >> 2, db = C.wave & 3;
    const int cp = lane, sg = C.wave;
    constexpr float L2E = 1.4426950408889634f;
    LAS f32x2_* AGG = (LAS f32x2_*)(C.lds + O_AGG);
    for (int item = C.vcu; item < 256; item += C.G) {
        const int n = item & 15, c = item >> 4, ch0 = n * 128, t0 = c * 512;
        f32x2_ cw0, cw1, cw2, cw3, cb;
        { const float* w = C.in[I_CONVW] + ch0 + 2 * cp; cw0 = *(const f32x2_*)w; cw1 = *(const f32x2_*)(w + DM); cw2 = *(const f32x2_*)(w + 2 * DM); cw3 = *(const f32x2_*)(w + 3 * DM); cb = *(const f32x2_*)(C.in[I_CONVB] + ch0 + 2 * cp); }
        const int dcol = db * 32 + r32;
        const float ba = C.in[I_BRGA][ch0 + dcol], bxb = C.in[I_BRGX][ch0 + dcol];
        const float sp8 = 8.0f * log1pf(__expf(-C.in[I_LAM][ch0 + dcol]));
        bf16x8_ wa[8], wx[8];
#pragma unroll
        for (int ks = 0; ks < 8; ++ks) { wa[ks] = *(const bf16x8_*)(WRG + (size_t)((n * 2 + 0) * 128 + dcol) * 128 + ks * 16 + hi * 8);
                                         wx[ks] = *(const bf16x8_*)(WRG + (size_t)((n * 2 + 1) * 128 + dcol) * 128 + ks * 16 + hi * 8); }
#define LBAR() do { asm volatile("s_waitcnt lgkmcnt(0)" ::: "memory"); __builtin_amdgcn_s_barrier(); asm volatile("" ::: "memory"); } while (0)
#define LRU_DMA(buf, tsub) do { \
            for (int r_ = C.wave; r_ < 67; r_ += 8) { int tt_ = (tsub) - 3 + r_; if (tt_ < 0) tt_ = 0; \
                __builtin_amdgcn_global_load_lds((const unsigned*)(P + (size_t)tt_ * INC + CXR + ch0 + 2 * lane), (LAS unsigned*)(C.lds + O_XR + (buf) * XRB + r_ * 256), 4, 0, 0); } } while (0)
#define LRU_CONV(sub) do { const LAS unsigned char* XR_ = C.lds + O_XR + ((sub) & 1) * XRB; LAS unsigned char* Ub_ = C.lds + O_UB + ((sub) & 1) * 16384; \
            f32x2_ x0 = bfpair(*(const LAS unsigned*)(XR_ + (sg * 8 + 0) * 256 + 4 * cp)), x1 = bfpair(*(const LAS unsigned*)(XR_ + (sg * 8 + 1) * 256 + 4 * cp)), x2_ = bfpair(*(const LAS unsigned*)(XR_ + (sg * 8 + 2) * 256 + 4 * cp)); \
            if (t0 + (sub) * 64 + sg * 8 == 0) { x0 = (f32x2_){0.f, 0.f}; x1 = x0; x2_ = x0; } \
            _Pragma("unroll") for (int k = 0; k < 8; ++k) { const int tr = sg * 8 + k; const f32x2_ x3 = bfpair(*(const LAS unsigned*)(XR_ + (tr + 3) * 256 + 4 * cp)); \
                const f32x2_ uu = cb + cw0 * x0 + cw1 * x1 + cw2 * x2_ + cw3 * x3; x0 = x1; x1 = x2_; x2_ = x3; \
                *(LAS unsigned*)(Ub_ + LSWZ(tr, 4 * cp)) = cvt_pk_bf16_(uu.x, uu.y); } } while (0)
        __syncthreads();
        LRU_DMA(0, t0); LRU_DMA(1, t0 + 64);
        asm volatile("s_waitcnt vmcnt(0)" ::: "memory"); LBAR();
        LRU_CONV(0);
        LBAR();
        for (int sc = 0; sc < 8; ++sc) {
            const int ts = t0 + sc * 64;
            if (sc + 2 < 8) LRU_DMA(sc & 1, ts + 128);
            if (sc > 0) { const LAS unsigned char* G_ = C.lds + O_G + ((sc - 1) & 1) * 16384; const LAS unsigned char* OI_ = C.lds + O_OI + ((sc - 1) & 1) * 16384;
#pragma unroll
                for (int i = 0; i < 2; ++i) { const int pc = C.tid + i * NTHR, tr = pc >> 4, cq = pc & 15; const size_t go = (size_t)(ts - 64 + tr) * 4096 + ch0 + cq * 8;
                    *(v4u*)(LX2 + go) = *(const LAS v4u*)(G_ + tr * 256 + cq * 16); *(v4u*)(LBX + go) = *(const LAS v4u*)(OI_ + tr * 256 + cq * 16); } }
            if (sc + 1 < 8) LRU_CONV(sc + 1);
            {
                const LAS unsigned char* Ub = C.lds + O_UB + (sc & 1) * 16384; LAS unsigned char* G = C.lds + O_G + (sc & 1) * 16384; LAS unsigned char* OUTI = C.lds + O_OI + (sc & 1) * 16384;
                f32x16_ accA = {}, accX = {};
#pragma unroll
                for (int ks = 0; ks < 8; ++ks) { const bf16x8_ af = *(const LAS bf16x8_*)(Ub + LSWZ(th * 32 + r32, (ks * 16 + hi * 8) * 2));
                    accA = __builtin_amdgcn_mfma_f32_32x32x16_bf16(af, wa[ks], accA, 0, 0, 0); accX = __builtin_amdgcn_mfma_f32_32x32x16_bf16(af, wx[ks], accX, 0, 0, 0); }
                f32x2_ x2v[8]; bool slow = false;
#pragma unroll
                for (int rp = 0; rp < 8; ++rp) { const f32x2_ za = ((f32x2_){accA[2 * rp], accA[2 * rp + 1]} + ba) * (-L2E);
                    x2v[rp] = rcp_2(exp2_2(za) + 1.f) * (-2.0f * sp8); slow |= (x2v[rp].x <= -0.25f) | (x2v[rp].y <= -0.25f); }
                const bool anyslow = __any(slow);
                float gA[4], gH[4];
#pragma unroll
                for (int rp = 0; rp < 8; ++rp) { const int r = 2 * rp; const int tr = th * 32 + (r & 3) + 8 * (r >> 2) + 4 * hi;
                    f32x2_ u; u.x = bf2f(*(const LAS unsigned short*)(Ub + LSWZ(tr, 2 * dcol))); u.y = bf2f(*(const LAS unsigned short*)(Ub + LSWZ(tr + 1, 2 * dcol)));
                    const f32x2_ zi = ((f32x2_){accX[r], accX[r + 1]} + bxb) * (-L2E); const f32x2_ ig = rcp_2(exp2_2(zi) + 1.f);
                    const f32x2_ x2 = x2v[rp]; const f32x2_ a = exp2_2(x2 * (0.5f * L2E));
                    f32x2_ om = -x2 * (x2 * (x2 * (x2 * (x2 * 0.008333334f + 0.041666668f) + 0.16666667f) + 0.5f) + 1.f);
                    if (anyslow) { const f32x2_ ex = exp2_2(x2 * L2E); om.x = (x2.x > -0.25f) ? om.x : 1.f - ex.x; om.y = (x2.y > -0.25f) ? om.y : 1.f - ex.y; }
                    f32x2_ sq; sq.x = __builtin_amdgcn_sqrtf(om.x); sq.y = __builtin_amdgcn_sqrtf(om.y);
                    const f32x2_ bx = sq * ig * u;
                    if ((rp & 1) == 0) { gA[rp >> 1] = a.x * a.y; gH[rp >> 1] = bx.x * a.y + bx.y; }
                    else { const float h1 = gH[rp >> 1] * a.x + bx.x; gH[rp >> 1] = h1 * a.y + bx.y; gA[rp >> 1] *= a.x * a.y; }
                    *(LAS unsigned short*)(G + tr * 256 + 2 * dcol) = (unsigned short)(cvt_pk_bf16_(x2.x, 0.f)); *(LAS unsigned short*)(G + (tr + 1) * 256 + 2 * dcol) = (unsigned short)(cvt_pk_bf16_(x2.y, 0.f));
                    *(LAS unsigned short*)(OUTI + tr * 256 + 2 * dcol) = (unsigned short)(cvt_pk_bf16_(bx.x, 0.f)); *(LAS unsigned short*)(OUTI + (tr + 1) * 256 + 2 * dcol) = (unsigned short)(cvt_pk_bf16_(bx.y, 0.f)); }
                float Aw = 1.f, Hw = 0.f;
#pragma unroll
                for (int g = 0; g < 4; ++g) { const auto ra = __builtin_amdgcn_permlane32_swap(__float_as_uint(gA[g]), __float_as_uint(gA[g]), false, false);
                    const auto rh = __builtin_amdgcn_permlane32_swap(__float_as_uint(gH[g]), __float_as_uint(gH[g]), false, false);
                    const float a0 = __uint_as_float(ra[0]), a1 = __uint_as_float(ra[1]), h0 = __uint_as_float(rh[0]), h1 = __uint_as_float(rh[1]);
                    Hw = a0 * Hw + h0; Hw = a1 * Hw + h1; Aw *= a0 * a1; }
                if (hi == 0) AGG[(sc * 2 + th) * 128 + dcol] = (f32x2_){Aw, Hw};
            }
            if (sc == 0) asm volatile("s_waitcnt vmcnt(0)" ::: "memory"); else asm volatile("s_waitcnt vmcnt(4)" ::: "memory");
            LBAR();
        }
        {
            const LAS unsigned char* G_ = C.lds + O_G + 16384; const LAS unsigned char* OI_ = C.lds + O_OI + 16384;
#pragma unroll
            for (int i = 0; i < 2; ++i) { const int pc = C.tid + i * NTHR, tr = pc >> 4, cq = pc & 15; const size_t go = (size_t)(t0 + 448 + tr) * 4096 + ch0 + cq * 8;
                *(v4u*)(LX2 + go) = *(const LAS v4u*)(G_ + tr * 256 + cq * 16); *(v4u*)(LBX + go) = *(const LAS v4u*)(OI_ + tr * 256 + cq * 16); }
            if (C.tid < 128) { float Ar = 1.f, Hr = 0.f;
#pragma unroll
                for (int k = 0; k < 16; ++k) { const f32x2_ ag = AGG[k * 128 + C.tid]; Hr = ag.x * Hr + ag.y; Ar *= ag.x; }
                *(f32x2_*)(LAGG + (size_t)(c * 2048 + ch0 + C.tid) * 2) = (f32x2_){Ar, Hr}; }
        }
    }
#undef LRU_CONV
#undef LRU_DMA
#undef LBAR
}

__device__ __forceinline__ void phase_lru_b(const Ctx& C) {
    const bf16* P = (const bf16*)(C.ws + WS_P); bf16* AL = (bf16*)(C.ws + WS_AL); const float* LAGG = (const float*)(C.ws + WS_LAGG);
    const bf16* LX2 = (const bf16*)(C.ws + WS_LX2); const bf16* LBX = (const bf16*)(C.ws + WS_LBX);
    LAS f32x4* SEG = (LAS f32x4*)(C.lds);
    const int cp = C.lane, sg = C.wave; constexpr float L2E = 1.4426950408889634f;
    for (int item = C.vcu; item < 256; item += C.G) {
        const int n = item & 15, c = item >> 4, ch0 = n * 128, t0 = c * 512;
        f32x2_ hst = {0.f, 0.f};
        for (int cc = 0; cc < c; ++cc) { const f32x4 ag = *(const f32x4*)(LAGG + (size_t)(cc * 2048 + ch0 + 2 * cp) * 2); hst.x = ag[0] * hst.x + ag[1]; hst.y = ag[2] * hst.y + ag[3]; }
        unsigned xw[8], bw[8], yw[8], xn[8], bn[8], yn[8];
#define LB_LOAD(X, B, Y, tsub) do { _Pragma("unroll") for (int k = 0; k < 8; ++k) { const size_t t_ = (size_t)((tsub) + sg * 8 + k); \
            X[k] = *(const unsigned*)(LX2 + t_ * 4096 + ch0 + 2 * cp); B[k] = *(const unsigned*)(LBX + t_ * 4096 + ch0 + 2 * cp); Y[k] = *(const unsigned*)(P + t_ * INC + CYR + ch0 + 2 * cp); } } while (0)
        LB_LOAD(xw, bw, yw, t0);
        __syncthreads();
        for (int sc = 0; sc < 8; ++sc) {
            const int ts = t0 + sc * 64; LAS f32x4* SG = SEG + (sc & 1) * 512;
            if (sc < 7) LB_LOAD(xn, bn, yn, ts + 64);
            f32x2_ av[8], bv[8]; f32x2_ ap = {1.f, 1.f}, hl = {0.f, 0.f};
#pragma unroll
            for (int k = 0; k < 8; ++k) { av[k] = exp2_2(bfpair(xw[k]) * (0.5f * L2E)); bv[k] = bfpair(bw[k]); hl = av[k] * hl + bv[k]; ap = ap * av[k]; }
            SG[sg * 64 + cp] = (f32x4){ap.x, ap.y, hl.x, hl.y};
            asm volatile("s_waitcnt lgkmcnt(0)" ::: "memory"); __builtin_amdgcn_s_barrier(); asm volatile("" ::: "memory");
            f32x2_ hin = hst, hrun = hst;
#pragma unroll
            for (int s = 0; s < 8; ++s) { const f32x4 sv = SG[s * 64 + cp]; const f32x2_ as_ = {sv[0], sv[1]}, hs_ = {sv[2], sv[3]}; if (s == sg) hin = hrun; hrun = as_ * hrun + hs_; }
            hst = hrun;
#pragma unroll
            for (int k = 0; k < 8; ++k) { hin = av[k] * hin + bv[k]; const f32x2_ y = bfpair(yw[k]);
                const f32x2_ e2 = exp2_2((y + (y * y) * y * 0.044715f) * (-1.5957691216057308f * L2E)); const f32x2_ yv = hin * y * rcp_2(e2 + 1.f);
                *(unsigned*)(AL + (size_t)(ts + sg * 8 + k) * 4096 + 2048 + ch0 + 2 * cp) = cvt_pk_bf16_(yv.x, yv.y); }
#pragma unroll
            for (int k = 0; k < 8; ++k) { xw[k] = xn[k]; bw[k] = bn[k]; yw[k] = yn[k]; }
        }
#undef LB_LOAD
    }
}

namespace pg8 {
typedef short bf16x8 __attribute__((ext_vector_type(8)));
typedef unsigned u32x4 __attribute__((ext_vector_type(4)));
constexpr int BM = 256, BK = 64, HALF = 128, HTB = HALF * BK * 2, STAGE_BYTES = 8 * HTB, NXCD = 8, WGM = 8;
__host__ __device__ __forceinline__ int lds_byte(int r, int c) { const int st = (r >> 4) * 2 + (c >> 5), rr = r & 15, cc = c & 31, ob = rr * 64 + cc * 2; return st * 1024 + (ob ^ (((ob >> 9) & 1) << 5)); }
__host__ __device__ __forceinline__ void stage_rc(int b, int& R, int& C) { const int st = b / 1024, sb = b % 1024, swz = sb ^ (((sb >> 9) & 1) << 5); R = (st >> 1) * 16 + swz / 64; C = (st & 1) * 32 + (swz % 64) / 2; }
__host__ __device__ __forceinline__ int perm32(int rho) { const int n = rho >> 4, i = rho & 15; return 8 * (i >> 2) + 4 * n + (i & 3); }
struct Unit { int pm, pn; };
struct Gemm { const bf16* A; const bf16* Bt; int lda, ldb, M, N, K; };
struct StaticOrder {
    int nM, nN, nwg, G, c;
    __device__ void init(int M, int N, int G_, int c_) { nM = M / BM; nN = N / BM; nwg = nM * nN; G = G_; c = c_; }
    __device__ bool next(int i, Unit& u) const {
        const long L = (long)i * G + c; if (L >= nwg) return false;
        int wgid = (int)L; { const int q = nwg / NXCD, r = nwg % NXCD, xcd = wgid % NXCD, off = wgid / NXCD; wgid = (xcd < r ? xcd * (q + 1) : r * (q + 1) + (xcd - r) * q) + off; }
        const int nig = WGM * nN, gid = wgid / nig, fm = gid * WGM, gsz = (nM - fm) < WGM ? (nM - fm) : WGM;
        u.pm = fm + ((wgid % nig) % gsz); u.pn = (wgid % nig) / gsz; return true;
    }
};
__device__ __forceinline__ unsigned cvt_pk_bf16(float lo, float hi) { unsigned r; asm volatile("v_cvt_pk_bf16_f32 %0, %1, %2" : "=v"(r) : "v"(lo), "v"(hi)); return r; }
typedef f32x4 Acc[2][2][4][2];

template <class Epi, bool ALIGN_EPI>
__device__ __forceinline__ void gemm_phase(LAS unsigned char* lds, const Gemm g, const StaticOrder& S, const Epi& E) {
    const int tid = threadIdx.x, wid = __builtin_amdgcn_readfirstlane(tid >> 6), lane = tid & 63, wr = wid >> 2, wc = wid & 3, fr = lane & 15, fq = lane >> 4;
    const int K = g.K, nt = K / BK;
    unsigned voffA[2], voffB[2];
#pragma unroll
    for (int i = 0; i < 2; ++i) { int R, C; stage_rc(tid * 16 + i * 8192, R, C); const int Rb = Epi::PERM ? ((R & ~31) + perm32(R & 31)) : R;
        voffA[i] = (unsigned)(R * g.lda + C) * 2u; voffB[i] = (unsigned)(Rb * g.ldb + C) * 2u; }
    const size_t kstep = (size_t)(BK * 2);
    const size_t hstepA = (size_t)HALF * g.lda * 2, hstepB = (size_t)HALF * g.ldb * 2;
    const size_t tstepA = 2 * hstepA, tstepB = 2 * hstepB;
    const unsigned ldsw = (unsigned)wid * 1024u;
    const int aoff = lds_byte(wr * 64 + fr, fq * 8), boff = lds_byte(wc * 32 + fr, fq * 8);
#define PG8_SA(b, h) (((b) * 2 + (h)) * HTB)
#define PG8_SB(b, h) ((4 + (b) * 2 + (h)) * HTB)
#define PG8_STAGE(bufoff, gbase, voff) do { _Pragma("unroll") for (int _i = 0; _i < 2; ++_i) \
        __builtin_amdgcn_global_load_lds((const unsigned*)((const char*)(gbase) + (voff)[_i]), (LAS unsigned*)(lds + (bufoff) + ldsw + _i * 8192), 16, 0, 0); } while (0)
#define PG8_LDA(dst, b, h) do { _Pragma("unroll") for (int m = 0; m < 4; ++m) _Pragma("unroll") for (int k = 0; k < 2; ++k) dst[m][k] = *(const LAS bf16x8*)(lds + PG8_SA(b, h) + aoff + m * 2048 + k * 1024); } while (0)
#define PG8_LDB(dst, b, h) do { _Pragma("unroll") for (int n = 0; n < 2; ++n) _Pragma("unroll") for (int k = 0; k < 2; ++k) dst[n][k] = *(const LAS bf16x8*)(lds + PG8_SB(b, h) + boff + n * 2048 + k * 1024); } while (0)
#define PG8_MMA(ai, bj, At, Bt) do { __builtin_amdgcn_s_setprio(1); _Pragma("unroll") for (int m = 0; m < 4; ++m) _Pragma("unroll") for (int n = 0; n < 2; ++n) _Pragma("unroll") for (int k = 0; k < 2; ++k) \
        acc[ai][bj][m][n] = __builtin_amdgcn_mfma_f32_16x16x32_bf16(Bt[n][k], At[m][k], acc[ai][bj][m][n], 0, 0, 0); __builtin_amdgcn_s_setprio(0); } while (0)
#define PG8_WAIT_V(n) asm volatile("s_waitcnt vmcnt(" #n ")" ::: "memory")
#define PG8_WAIT_L(n) asm volatile("s_waitcnt lgkmcnt(" #n ")" ::: "memory")
#define PG8_BAR __builtin_amdgcn_s_barrier()
#define PG8_SCHED __builtin_amdgcn_sched_barrier(0)
    Unit cur, nxt; int ui = 0;
    if (!S.next(0, cur)) return;
    Acc acc;
#pragma unroll
    for (int a = 0; a < 2; ++a)
#pragma unroll
        for (int b = 0; b < 2; ++b)
#pragma unroll
            for (int m = 0; m < 4; ++m)
#pragma unroll
                for (int n = 0; n < 2; ++n) acc[a][b][m][n] = (f32x4){0.f, 0.f, 0.f, 0.f};
    bf16x8 At[4][2], B0[2][2], B1[2][2];
    const char* cA = (const char*)g.A + (size_t)cur.pm * tstepA; const char* cB = (const char*)g.Bt + (size_t)cur.pn * tstepB;
    PG8_STAGE(PG8_SB(0, 0), cB, voffB); PG8_STAGE(PG8_SB(0, 1), cB + hstepB, voffB); PG8_STAGE(PG8_SA(0, 0), cA, voffA); PG8_STAGE(PG8_SA(0, 1), cA + hstepA, voffA);
    if (wr == 1) PG8_BAR;
    PG8_WAIT_V(2); PG8_BAR;
    PG8_STAGE(PG8_SB(1, 0), cB + kstep, voffB); PG8_STAGE(PG8_SA(1, 0), cA + kstep, voffA); PG8_STAGE(PG8_SB(1, 1), cB + hstepB + kstep, voffB);
    PG8_WAIT_V(6); PG8_BAR;
    for (;;) {
        const bool has_next = S.next(ui + 1, nxt);
        const char* nA = has_next ? (const char*)g.A + (size_t)nxt.pm * tstepA : cA; const char* nB = has_next ? (const char*)g.Bt + (size_t)nxt.pn * tstepB : cB;
        for (int t = 0; t < nt; t += 2) {
            if constexpr (Epi::MIDK) { if (t == (nt >> 1)) E.mid(acc, cur, wr, wc, fr, fq); }
            const bool last = (t == nt - 2);
            const char* a1 = cA + (size_t)(t + 1) * kstep;
            const char* a2 = last ? nA : cA + (size_t)(t + 2) * kstep; const char* b2 = last ? nB : cB + (size_t)(t + 2) * kstep;
            const char* a3 = a2 + kstep; const char* b3 = b2 + kstep;
            PG8_LDB(B0, 0, 0); PG8_LDB(B1, 0, 1); PG8_SCHED; PG8_LDA(At, 0, 0); PG8_STAGE(PG8_SA(1, 1), a1 + hstepA, voffA);
            PG8_WAIT_V(8); PG8_WAIT_L(0); PG8_BAR; PG8_MMA(0, 0, At, B0); PG8_MMA(0, 1, At, B1); PG8_BAR; PG8_SCHED;
            PG8_LDA(At, 0, 1); PG8_STAGE(PG8_SB(0, 0), b2, voffB); PG8_STAGE(PG8_SB(0, 1), b2 + hstepB, voffB); PG8_STAGE(PG8_SA(0, 0), a2, voffA);
            PG8_WAIT_V(8); PG8_WAIT_L(0); PG8_BAR; PG8_MMA(1, 0, At, B0); PG8_MMA(1, 1, At, B1); PG8_BAR; PG8_SCHED;
            PG8_LDB(B0, 1, 0); PG8_LDB(B1, 1, 1); PG8_SCHED; PG8_LDA(At, 1, 0); PG8_STAGE(PG8_SA(0, 1), a2 + hstepA, voffA);
            PG8_WAIT_V(8); PG8_WAIT_L(0); PG8_BAR; PG8_MMA(0, 0, At, B0); PG8_MMA(0, 1, At, B1); PG8_BAR; PG8_SCHED;
            PG8_LDA(At, 1, 1); PG8_STAGE(PG8_SB(1, 0), b3, voffB); PG8_STAGE(PG8_SB(1, 1), b3 + hstepB, voffB); PG8_STAGE(PG8_SA(1, 0), a3, voffA);
            PG8_WAIT_V(8); PG8_WAIT_L(0); PG8_BAR; PG8_MMA(1, 0, At, B0); PG8_MMA(1, 1, At, B1); PG8_BAR; PG8_SCHED;
        }
        if constexpr (ALIGN_EPI) { if (wr == 0) PG8_BAR; }
        E(acc, cur, ui, wr, wc, fr, fq);
        if (!has_next) break;
#pragma unroll
        for (int a = 0; a < 2; ++a)
#pragma unroll
            for (int b = 0; b < 2; ++b)
#pragma unroll
                for (int m = 0; m < 4; ++m)
#pragma unroll
                    for (int n = 0; n < 2; ++n) acc[a][b][m][n] = (f32x4){0.f, 0.f, 0.f, 0.f};
        cur = nxt; cA = nA; cB = nB; ++ui;
        if constexpr (ALIGN_EPI) { if (wr == 1) PG8_BAR; }
    }
    PG8_WAIT_V(0);
    if constexpr (!ALIGN_EPI) { if (wr == 0) PG8_BAR; }
    PG8_BAR;
#undef PG8_SA
#undef PG8_SB
#undef PG8_STAGE
#undef PG8_LDA
#undef PG8_LDB
#undef PG8_MMA
#undef PG8_WAIT_V
#undef PG8_WAIT_L
#undef PG8_BAR
#undef PG8_SCHED
}

__device__ __forceinline__ u32x4 pack8(const f32x4 v0, const f32x4 v1) { u32x4 w; w.x = cvt_pk_bf16(v0[0], v0[1]); w.y = cvt_pk_bf16(v0[2], v0[3]); w.z = cvt_pk_bf16(v1[0], v1[1]); w.w = cvt_pk_bf16(v1[2], v1[3]); return w; }
__device__ __forceinline__ void unpack8(const u32x4 w, float (&f)[8]) { f[0] = bflo(w.x); f[1] = bfhi(w.x); f[2] = bflo(w.y); f[3] = bfhi(w.y); f[4] = bflo(w.z); f[5] = bfhi(w.z); f[6] = bflo(w.w); f[7] = bfhi(w.w); }
struct EpiP { static constexpr bool PERM = true, MIDK = false; bf16* P; const LAS float* rst; const LAS float* wtab; float* kmean; LAS float* red;
    __device__ __forceinline__ void operator()(Acc& acc, const Unit& u, int ui, int wr, int wc, int fr, int fq) const {
        const int row0 = u.pm * BM + wr * 64 + fr, col0 = u.pn * BM + wc * 32 + 8 * fq;
        if (u.pn >= 40) {
#pragma unroll
            for (int ai = 0; ai < 2; ++ai)
#pragma unroll
                for (int m = 0; m < 4; ++m) { const int rowl = ai * HALF + wr * 64 + m * 16 + fr; const float rs = rst[ui * 256 + rowl] * (-1.4426950408889634f);
                    unsigned char* rowp = (unsigned char*)(P + (size_t)(u.pm * BM + rowl) * INC + CGA) + (col0 - CGA);
#pragma unroll
                    for (int bj = 0; bj < 2; ++bj) { unsigned w[2];
#pragma unroll
                        for (int n = 0; n < 2; ++n) { unsigned q4 = 0;
#pragma unroll
                            for (int e = 0; e < 4; ++e) { const float sg = __builtin_amdgcn_rcpf(1.f + __builtin_amdgcn_exp2f(acc[ai][bj][m][n][e] * rs));
                                unsigned q = (unsigned)(sg * 255.f + 0.5f); q = q < 1u ? 1u : q; q4 |= q << (8 * e); }
                            w[n] = q4; }
                        v2u o = {w[0], w[1]}; *(v2u*)(rowp + bj * HALF) = o; } }
            return;
        }
        if (u.pn >= 16) {
#pragma unroll
            for (int ai = 0; ai < 2; ++ai)
#pragma unroll
                for (int m = 0; m < 4; ++m) { const int rowl = ai * HALF + wr * 64 + m * 16 + fr; const float rs = rst[ui * 256 + rowl]; bf16* rowp = P + (size_t)(u.pm * BM + rowl) * INC + col0;
#pragma unroll
                    for (int bj = 0; bj < 2; ++bj) *(u32x4*)(rowp + bj * HALF) = pack8(acc[ai][bj][m][0] * rs, acc[ai][bj][m][1] * rs); }
            return;
        }
        const bool isK = u.pn >= 8;
        asm volatile("" : "+v"(fr), "+v"(fq));
#pragma unroll
        for (int ai = 0; ai < 2; ++ai)
#pragma unroll
            for (int m = 0; m < 4; ++m) { const int rowl = ai * HALF + wr * 64 + m * 16 + fr; const float rs = rst[ui * 256 + rowl];
#pragma unroll
                for (int bj = 0; bj < 2; ++bj) { const f32x4 a = acc[ai][bj][m][0] * rs, b = acc[ai][bj][m][1] * rs;
                    float ss = ((a[0] * a[0] + a[1] * a[1]) + (a[2] * a[2] + a[3] * a[3])) + ((b[0] * b[0] + b[1] * b[1]) + (b[2] * b[2] + b[3] * b[3]));
                    ss += __shfl_xor(ss, 16); ss += __shfl_xor(ss, 32);
                    if (fq == 0) red[(rowl * 2 + bj) * 4 + wc] = ss; }
                __builtin_amdgcn_sched_barrier(0); }
        asm volatile("s_waitcnt lgkmcnt(0)" ::: "memory"); __builtin_amdgcn_s_barrier(); asm volatile("" ::: "memory");
        int pmv = u.pm, c0v = col0; asm volatile("" : "+v"(pmv), "+v"(c0v));
        const LAS float* wsrc = wtab + (isK ? 128 : 0) + wc * 32 + 8 * fq;
        const f32x4 w0 = *(const LAS f32x4*)wsrc, w1 = *(const LAS f32x4*)(wsrc + 4);
#pragma unroll
        for (int ai = 0; ai < 2; ++ai)
#pragma unroll
            for (int m = 0; m < 4; ++m) { int ro = ai * HALF + m * 16; asm volatile("" : "+v"(ro));
                const int rowl = ro + wr * 64 + fr; bf16* rowp = P + (size_t)(pmv * BM + rowl) * INC + c0v; const float rs = rst[ui * 256 + rowl];
#pragma unroll
                for (int bj = 0; bj < 2; ++bj) { const f32x4 t4 = *(const LAS f32x4*)(red + (rowl * 2 + bj) * 4);
                    const float tot = (t4[0] + t4[1]) + (t4[2] + t4[3]); const float rn = rs * __builtin_amdgcn_rsqf(tot * (1.f / HD) + EPS);
                    const f32x4 v0 = acc[ai][bj][m][0] * rn * w0, v1 = acc[ai][bj][m][1] * rn * w1;
                    *(u32x4*)(rowp + bj * HALF) = pack8(v0, v1); }
                __builtin_amdgcn_sched_barrier(0); }
        if (isK) {
            LAS float* csum = red + 2048;
            f32x4 cs[2][2];
#pragma unroll
            for (int bj = 0; bj < 2; ++bj) { cs[bj][0] = (f32x4){0.f, 0.f, 0.f, 0.f}; cs[bj][1] = (f32x4){0.f, 0.f, 0.f, 0.f}; }
#pragma unroll
            for (int ai = 0; ai < 2; ++ai)
#pragma unroll
                for (int m = 0; m < 4; ++m) { int ro = ai * HALF + m * 16; asm volatile("" : "+v"(ro));
                    const int rowl = ro + wr * 64 + fr; const float rs = rst[ui * 256 + rowl];
#pragma unroll
                    for (int bj = 0; bj < 2; ++bj) { const f32x4 t4 = *(const LAS f32x4*)(red + (rowl * 2 + bj) * 4);
                        const float tot = (t4[0] + t4[1]) + (t4[2] + t4[3]); const float rn = rs * __builtin_amdgcn_rsqf(tot * (1.f / HD) + EPS);
                        cs[bj][0] += acc[ai][bj][m][0] * rn * w0; cs[bj][1] += acc[ai][bj][m][1] * rn * w1; }
                    __builtin_amdgcn_sched_barrier(0); }
            float cv[16];
#pragma unroll
            for (int i = 0; i < 16; ++i) cv[i] = cs[i >> 3][(i >> 2) & 1][i & 3];
#pragma unroll
            for (int st = 0; st < 4; ++st) { const int half = 8 >> st; const bool bit = (fr & half) != 0;
#pragma unroll
                for (int i = 0; i < half; ++i) { const float keep = bit ? cv[i + half] : cv[i], send = bit ? cv[i] : cv[i + half]; cv[i] = keep + __shfl_xor(send, half); } }
            csum[wr * 256 + (fr >> 3) * HALF + wc * 32 + 8 * fq + (fr & 7)] = cv[0];
            asm volatile("s_waitcnt lgkmcnt(0)" ::: "memory"); __builtin_amdgcn_s_barrier(); asm volatile("" ::: "memory");
            const int tid = threadIdx.x;
            if (tid < 256) kmean[(((u.pn - 8) * 2 + (tid >> 7)) * NBLK + u.pm) * HD + (tid & 127)] = (csum[tid] + csum[256 + tid]) * (1.f / BLK);
        }
    }
};
struct EpiMrg { static constexpr bool PERM = true, MIDK = true; const bf16* P; bf16* mrg;
    __device__ __forceinline__ static void ub8(const v2u w, float (&f)[8]) {
#pragma unroll
        for (int e = 0; e < 4; ++e) { f[e] = (float)((w.x >> (8 * e)) & 255u); f[4 + e] = (float)((w.y >> (8 * e)) & 255u); } }
    __device__ __forceinline__ void mid(Acc& acc, const Unit& u, int wr, int wc, int fr, int fq) const {
        int row0 = u.pm * BM + wr * 64 + fr, col0 = u.pn * BM + wc * 32 + 8 * fq;
        asm volatile("" : "+v"(row0), "+v"(col0));
#pragma unroll
        for (int ai = 0; ai < 2; ++ai) { v2u ga[4][2], gl[4][2];
#pragma unroll
            for (int m = 0; m < 4; ++m) { const unsigned char* rowp = (const unsigned char*)(P + (size_t)(row0 + ai * HALF + m * 16) * INC + CGA) + col0;
#pragma unroll
                for (int bj = 0; bj < 2; ++bj) { ga[m][bj] = *(const v2u*)(rowp + bj * HALF); gl[m][bj] = *(const v2u*)(rowp + 2048 + bj * HALF); } }
#pragma unroll
            for (int m = 0; m < 4; ++m)
#pragma unroll
                for (int bj = 0; bj < 2; ++bj) { float a[8], l[8]; ub8(ga[m][bj], a); ub8(gl[m][bj], l);
#pragma unroll
                    for (int e = 0; e < 8; ++e) acc[ai][bj][m][e >> 2][e & 3] *= a[e] * __builtin_amdgcn_rcpf(l[e]); }
            asm volatile("" ::: "memory"); }
    }
    __device__ __forceinline__ void operator()(const Acc& acc, const Unit& u, int ui, int wr, int wc, int fr, int fq) const {
        const int row0 = u.pm * BM + wr * 64 + fr, col0 = u.pn * BM + wc * 32 + 8 * fq;
#pragma unroll
        for (int ai = 0; ai < 2; ++ai) { v2u gl[4][2];
#pragma unroll
            for (int m = 0; m < 4; ++m) { const unsigned char* rowp = (const unsigned char*)(P + (size_t)(row0 + ai * HALF + m * 16) * INC + CGA) + col0;
#pragma unroll
                for (int bj = 0; bj < 2; ++bj) gl[m][bj] = *(const v2u*)(rowp + 2048 + bj * HALF); }
#pragma unroll
            for (int m = 0; m < 4; ++m) { const int r = row0 + ai * HALF + m * 16;
#pragma unroll
                for (int bj = 0; bj < 2; ++bj) { float l[8]; ub8(gl[m][bj], l); f32x4 v0, v1;
#pragma unroll
                    for (int e = 0; e < 4; ++e) { v0[e] = acc[ai][bj][m][0][e] * (l[e] * (1.f / 255.f)); v1[e] = acc[ai][bj][m][1][e] * (l[4 + e] * (1.f / 255.f)); }
                    *(u32x4*)(mrg + (size_t)r * DM + col0 + bj * HALF) = pack8(v0, v1); } }
            asm volatile("" ::: "memory"); }
    }
};
struct EpiX1 { static constexpr bool PERM = false, MIDK = false; const float* x; float* out; bf16* x1b; float* ssq;
    __device__ __forceinline__ void operator()(const Acc& acc, const Unit& u, int ui, int wr, int wc, int fr, int fq) const {
        const int row0 = u.pm * BM + wr * 64 + fr, col0 = u.pn * BM + wc * 32 + 4 * fq;
#pragma unroll
        for (int ai = 0; ai < 2; ++ai) { f32x4 xv[4][2][2];
#pragma unroll
            for (int m = 0; m < 4; ++m) { const size_t off = (size_t)(row0 + ai * HALF + m * 16) * DM + col0;
#pragma unroll
                for (int bj = 0; bj < 2; ++bj)
#pragma unroll
                    for (int n = 0; n < 2; ++n) xv[m][bj][n] = *(const f32x4*)(x + off + bj * HALF + n * 16); }
#pragma unroll
            for (int m = 0; m < 4; ++m) { const int r = row0 + ai * HALF + m * 16; const size_t off = (size_t)r * DM + col0; float ss = 0.f;
#pragma unroll
                for (int bj = 0; bj < 2; ++bj)
#pragma unroll
                    for (int n = 0; n < 2; ++n) { const f32x4 v = xv[m][bj][n] + acc[ai][bj][m][n];
                        v2u w; w.x = cvt_pk_bf16(v[0], v[1]); w.y = cvt_pk_bf16(v[2], v[3]); *(v2u*)(x1b + off + bj * HALF + n * 16) = w;
                        ss += (v[0] * v[0] + v[1] * v[1]) + (v[2] * v[2] + v[3] * v[3]); }
                ss += __shfl_xor(ss, 16); ss += __shfl_xor(ss, 32);
                if (fq == 0) ssq[r * 32 + u.pn * 4 + wc] = ss; }
            asm volatile("" ::: "memory"); }
    }
};
struct EpiAct { static constexpr bool PERM = true, MIDK = false; const LAS float* rst; bf16* act;
    __device__ __forceinline__ void operator()(const Acc& acc, const Unit& u, int ui, int wr, int wc, int fr, int fq) const {
        const int col0 = u.pn * HALF + wc * 32 + 8 * fq;
#pragma unroll
        for (int ai = 0; ai < 2; ++ai)
#pragma unroll
            for (int m = 0; m < 4; ++m) { const int rowl = ai * HALF + wr * 64 + m * 16 + fr; const float rs = rst[ui * 256 + rowl];
                f32x4 v0, v1;
#pragma unroll
                for (int e = 0; e < 4; ++e) { const float g0 = acc[ai][0][m][0][e] * rs, u0 = acc[ai][1][m][0][e] * rs, g1 = acc[ai][0][m][1][e] * rs, u1 = acc[ai][1][m][1][e] * rs;
                    v0[e] = g0 * __builtin_amdgcn_rcpf(1.f + __expf(-g0)) * u0; v1[e] = g1 * __builtin_amdgcn_rcpf(1.f + __expf(-g1)) * u1; }
                *(u32x4*)(act + (size_t)(u.pm * BM + rowl) * DFF + col0) = pack8(v0, v1); }
    }
};
struct EpiOut { static constexpr bool PERM = false, MIDK = false; const bf16* x1b; float* out;
    __device__ __forceinline__ void operator()(const Acc& acc, const Unit& u, int ui, int wr, int wc, int fr, int fq) const {
        const int row0 = u.pm * BM + wr * 64 + fr, col0 = u.pn * BM + wc * 32 + 4 * fq;
#pragma unroll
        for (int ai = 0; ai < 2; ++ai) { v2u xv[4][2][2];
#pragma unroll
            for (int m = 0; m < 4; ++m) { const size_t off = (size_t)(row0 + ai * HALF + m * 16) * DM + col0;
#pragma unroll
                for (int bj = 0; bj < 2; ++bj)
#pragma unroll
                    for (int n = 0; n < 2; ++n) xv[m][bj][n] = *(const v2u*)(x1b + off + bj * HALF + n * 16); }
#pragma unroll
            for (int m = 0; m < 4; ++m) { const size_t off = (size_t)(row0 + ai * HALF + m * 16) * DM + col0;
#pragma unroll
                for (int bj = 0; bj < 2; ++bj)
#pragma unroll
                    for (int n = 0; n < 2; ++n) { const v2u w = xv[m][bj][n]; const f32x4 r = {bflo(w.x), bfhi(w.x), bflo(w.y), bfhi(w.y)};
                        *(f32x4*)(out + off + bj * HALF + n * 16) = r + acc[ai][bj][m][n]; } }
            asm volatile("" ::: "memory"); }
    }
};
struct EpiNull { static constexpr bool PERM = true, MIDK = false;
    __device__ __forceinline__ void operator()(const Acc& acc, const Unit&, int, int, int, int, int) const {
#pragma unroll
        for (int ai = 0; ai < 2; ++ai)
#pragma unroll
            for (int bj = 0; bj < 2; ++bj)
#pragma unroll
                for (int m = 0; m < 4; ++m)
#pragma unroll
                    for (int n = 0; n < 2; ++n) asm volatile("" :: "v"(acc[ai][bj][m][n]));
    }
};
}


namespace att {
typedef short bf16x8 __attribute__((ext_vector_type(8)));
typedef short s16x4 __attribute__((ext_vector_type(4)));
typedef float f32x16 __attribute__((ext_vector_type(16)));
constexpr int KT = 16384;
constexpr int L_K = 0, L_V = 65536, L_WS = 131072, L_PREF = 131072 + 4096;
constexpr float LOG2E = 1.4426950408889634f;
constexpr float QSCALE = ATT_SCALE * LOG2E;
#define KSWZ(row, colB) ((row) * 256 + ((colB) ^ (((row) & 15) << 4)))
#define SBAR() __builtin_amdgcn_sched_barrier(0)
__device__ __forceinline__ int v_st(int k, int c) { const int kk = (k & ~0xC) | ((k & 4) << 1) | ((k & 8) >> 1); return ((kk >> 3) * 4 + (c >> 5)) * 512 + ((kk & 7) * 32 + (c & 31)) * 2; }
__device__ __forceinline__ int v_rd_base(int lane) { return ((lane & 3) << 3) | (((lane >> 2) & 3) << 6) | (((lane >> 4) & 1) << 5) | (((lane >> 5) & 1) << 8); }
__device__ __forceinline__ int crow(int r, int hi) { return (r & 3) + 8 * (r >> 2) + 4 * hi; }
__device__ __forceinline__ unsigned cvtpk(float lo, float hi) { unsigned r; asm volatile("v_cvt_pk_bf16_f32 %0, %1, %2" : "=v"(r) : "v"(lo), "v"(hi)); return r; }

__device__ __forceinline__ void stage_kv(LAS unsigned char* lds, const bf16* P, int j, int h, int tid) {
    const int sr = tid >> 4, sc = (tid & 15) * 8;
    const bf16* kb = P + (size_t)(j * BLK + sr) * INC + CK + h * HD + sc;
    const bf16* vb = P + (size_t)(j * BLK + sr) * INC + CV + h * HD + sc;
    v4u kr[8], vr[8];
#pragma unroll
    for (int i = 0; i < 8; ++i) { kr[i] = *(const v4u*)(kb + (size_t)(i * 32) * INC); vr[i] = *(const v4u*)(vb + (size_t)(i * 32) * INC); }
    const int kws = KSWZ(sr, sc * 2), vs0 = v_st(sr, sc), vs1 = v_st(32 + sr, sc);
#pragma unroll
    for (int i = 0; i < 8; ++i) { const int tile = i >> 1, half = i & 1;
        *(LAS v4u*)(lds + L_K + tile * KT + kws + half * 32 * 256) = kr[i];
        *(LAS v4u*)(lds + L_V + tile * KT + (half ? vs1 : vs0)) = vr[i]; }
}
__device__ __forceinline__ void qkt(f32x16& p0, f32x16& p1, const LAS unsigned char* Kt, int r32, int hi, const bf16x8* qr) {
#define KLD(X0, X1, d0) do { const LAS unsigned char* a_ = Kt + KSWZ(r32, ((d0) * 16 + hi * 8) * 2); X0 = *(const LAS bf16x8*)a_; X1 = *(const LAS bf16x8*)(a_ + 32 * 256); } while (0)
    bf16x8 a0, a1, b0, b1;
    KLD(a0, a1, 0);
#pragma unroll
    for (int d0 = 0; d0 < 8; d0 += 2) {
        KLD(b0, b1, d0 + 1); SBAR();
        p0 = __builtin_amdgcn_mfma_f32_32x32x16_bf16(a0, qr[d0], p0, 0, 0, 0); p1 = __builtin_amdgcn_mfma_f32_32x32x16_bf16(a1, qr[d0], p1, 0, 0, 0); SBAR();
        if (d0 + 2 < 8) { KLD(a0, a1, d0 + 2); SBAR(); }
        p0 = __builtin_amdgcn_mfma_f32_32x32x16_bf16(b0, qr[d0 + 1], p0, 0, 0, 0); p1 = __builtin_amdgcn_mfma_f32_32x32x16_bf16(b1, qr[d0 + 1], p1, 0, 0, 0); SBAR();
    }
#undef KLD
}
__device__ __forceinline__ void pv_tile(f32x16* o, int vb, bf16x8 pa0, bf16x8 pa1, bf16x8 pa2, bf16x8 pa3) {
#define TRRD(dst, off) asm volatile("ds_read_b64_tr_b16 %0, %1 offset:%2" : "=&v"(dst) : "v"(vb), "i"(off) : "memory")
#define PV_RD(S, d0) do { constexpr int b_ = (d0) * 512; TRRD(S##l0, b_); TRRD(S##h0, b_ + 2048); TRRD(S##l1, b_ + 4096); TRRD(S##h1, b_ + 6144); TRRD(S##l2, b_ + 8192); TRRD(S##h2, b_ + 10240); TRRD(S##l3, b_ + 12288); TRRD(S##h3, b_ + 14336); } while (0)
#define PV_MM(S, d0) do { \
        o[d0] = __builtin_amdgcn_mfma_f32_32x32x16_bf16(pa0, (bf16x8){S##l0[0], S##l0[1], S##l0[2], S##l0[3], S##h0[0], S##h0[1], S##h0[2], S##h0[3]}, o[d0], 0, 0, 0); \
        o[d0] = __builtin_amdgcn_mfma_f32_32x32x16_bf16(pa1, (bf16x8){S##l1[0], S##l1[1], S##l1[2], S##l1[3], S##h1[0], S##h1[1], S##h1[2], S##h1[3]}, o[d0], 0, 0, 0); \
        o[d0] = __builtin_amdgcn_mfma_f32_32x32x16_bf16(pa2, (bf16x8){S##l2[0], S##l2[1], S##l2[2], S##l2[3], S##h2[0], S##h2[1], S##h2[2], S##h2[3]}, o[d0], 0, 0, 0); \
        o[d0] = __builtin_amdgcn_mfma_f32_32x32x16_bf16(pa3, (bf16x8){S##l3[0], S##l3[1], S##l3[2], S##l3[3], S##h3[0], S##h3[1], S##h3[2], S##h3[3]}, o[d0], 0, 0, 0); } while (0)
    s16x4 Al0, Al1, Al2, Al3, Ah0, Ah1, Ah2, Ah3, Bl0, Bl1, Bl2, Bl3, Bh0, Bh1, Bh2, Bh3;
    PV_RD(A, 0); PV_RD(B, 1);
    asm volatile("s_waitcnt lgkmcnt(8)" ::: "memory"); SBAR(); PV_MM(A, 0); SBAR();
    PV_RD(A, 2);
    asm volatile("s_waitcnt lgkmcnt(8)" ::: "memory"); SBAR(); PV_MM(B, 1); SBAR();
    PV_RD(B, 3);
    asm volatile("s_waitcnt lgkmcnt(8)" ::: "memory"); SBAR(); PV_MM(A, 2); SBAR();
    asm volatile("s_waitcnt lgkmcnt(0)" ::: "memory"); SBAR(); PV_MM(B, 3);
#undef PV_MM
#undef PV_RD
#undef TRRD
}
__device__ __forceinline__ void softmax_tile(f32x16& p0, f32x16& p1, float& l_reg, bf16x8& pa0, bf16x8& pa1, bf16x8& pa2, bf16x8& pa3) {
#pragma unroll
    for (int r = 0; r < 16; ++r) { p0[r] = __builtin_amdgcn_exp2f(p0[r]); p1[r] = __builtin_amdgcn_exp2f(p1[r]); }
    float ps = 0.f;
#pragma unroll
    for (int r = 0; r < 16; ++r) ps += p0[r];
#pragma unroll
    for (int r = 0; r < 16; ++r) ps += p1[r];
    l_reg += ps;
#define PK4(Pv, B_, OUT) do { unsigned a0 = cvtpk(Pv[B_ + 0], Pv[B_ + 1]), a1 = cvtpk(Pv[B_ + 2], Pv[B_ + 3]); \
        unsigned b0 = cvtpk(Pv[B_ + 4], Pv[B_ + 5]), b1 = cvtpk(Pv[B_ + 6], Pv[B_ + 7]); \
        auto r0 = __builtin_amdgcn_permlane32_swap(a0, b0, false, false); auto r1 = __builtin_amdgcn_permlane32_swap(a1, b1, false, false); \
        v4u w = {r0[0], r1[0], r0[1], r1[1]}; OUT = __builtin_bit_cast(bf16x8, w); } while (0)
    PK4(p0, 0, pa0); PK4(p0, 8, pa1); PK4(p1, 0, pa2); PK4(p1, 8, pa3);
#undef PK4
}
__device__ __forceinline__ void init_bias(f32x16& p0, f32x16& p1, int kbase, int tile, int tq, float sl2, float ref, int hi) {
    const float base = sl2 * (float)(kbase + tile * 64 + 4 * hi - tq) - ref;
#pragma unroll
    for (int r = 0; r < 16; ++r) { const float c = base + sl2 * (float)((r & 3) + 8 * (r >> 2)); p0[r] = c; p1[r] = c + 32.f * sl2; }
}
__device__ __forceinline__ void mask_diag(f32x16& p0, f32x16& p1, int tile, int qloc, int hi) {
    const int dq = qloc - tile * 64 - 4 * hi; const float NEG = -__builtin_inff();
#pragma unroll
    for (int r = 0; r < 16; ++r) { const int c = (r & 3) + 8 * (r >> 2); if (dq - c < 0) p0[r] = NEG; if (dq - c - 32 < 0) p1[r] = NEG; }
}
template <bool MASKLAST>
__device__ __forceinline__ void block_pass(int ntile, const LAS unsigned char* lds, int vb0, bf16x8* qr, const bf16* nextq, int e_next, int kbase, int tq, float sl2, float ref, int r32, int hi, int qloc,
                                           float& l_reg, f32x16* o, int var = 0) {
#pragma unroll 1
    for (int tile = 0; tile < ntile; ++tile) {
        f32x16 p0, p1; bf16x8 pa0 = {}, pa1 = {}, pa2 = {}, pa3 = {};
        init_bias(p0, p1, kbase, tile, tq, sl2, ref, hi); if (!(var & 32)) qkt(p0, p1, lds + L_K + tile * KT, r32, hi, qr);
        if (nextq && tile + 1 == ntile) {
            const bf16* nq_ = nextq + (size_t)(e_next & 255) * INC;
#pragma unroll
            for (int d0 = 0; d0 < 8; ++d0) qr[d0] = *(const bf16x8*)(nq_ + d0 * 16); }
        if (MASKLAST && tile + 1 == ntile) mask_diag(p0, p1, tile, qloc, hi);
        if (!(var & 16)) softmax_tile(p0, p1, l_reg, pa0, pa1, pa2, pa3);
        SBAR();
        if (!(var & 8)) pv_tile(o, vb0 + tile * KT, pa0, pa1, pa2, pa3);
    }
}
__device__ __forceinline__ float att_ref(const float* qw, const float* kw, int lane) {
    float a = fmaxf(fabsf(qw[lane]), fabsf(qw[lane + 64])), b = fmaxf(fabsf(kw[lane]), fabsf(kw[lane + 64]));
#pragma unroll
    for (int o_ = 1; o_ < 64; o_ <<= 1) { a = fmaxf(a, __shfl_xor(a, o_)); b = fmaxf(b, __shfl_xor(b, o_)); }
    return fmaxf(0.f, 128.f * a * b * QSCALE - 64.f);
}
constexpr int ATT_SC = 6, ATT_CC = 10;
}

__device__ __forceinline__ void phase_attp(const Ctx& C) {
    using namespace att;
    const bf16* P = (const bf16*)(C.ws + WS_P); const int* CNT = (const int*)(C.ws + WS_CNT); const unsigned short* LIST = (const unsigned short*)(C.ws + WS_LIST);
    bf16* PO = (bf16*)(C.ws + WS_PO); float* ML = (float*)(C.ws + WS_ML);
    const int lane = C.lane, r32 = lane & 31, hi = lane >> 5, wid = C.wave;
    LAS float* wsf = (LAS float*)(C.lds + L_WS) + wid * 128; LAS int* rd_l = (LAS int*)(wsf + 64);
    LAS unsigned char* ost = C.lds + 143360 + wid * 2048;
    const float ref = att_ref(C.in[I_QNW], C.in[I_KNW], lane);
    LAS int* pref = (LAS int*)(C.lds + L_PREF);
    LAS int* segp = (LAS int*)(C.lds + L_PREF + 256);
    LAS int* wsum = (LAS int*)(C.lds + L_PREF + 256 + 2048);
    const int vb0 = (int)(uintptr_t)(C.lds + L_V) + v_rd_base(lane);
    constexpr int NSEG = 31 * NH;
    if (__builtin_amdgcn_readfirstlane(threadIdx.x) >= 256) __builtin_amdgcn_s_setprio(1);
    __syncthreads();
    {
        int cst = 0;
        if (C.tid < NSEG) { const int j = C.tid >> 4, h = C.tid & 15; const int* cp = CNT + (h * NBLK + j) * NBLK; int n = 0;
            typedef int i32x4 __attribute__((ext_vector_type(4))); i32x4 cv[8];
#pragma unroll
            for (int q4 = 0; q4 < 8; ++q4) cv[q4] = ((const i32x4*)cp)[q4];
#pragma unroll
            for (int q4 = 0; q4 < 8; ++q4)
#pragma unroll
                for (int e = 0; e < 4; ++e) n += (q4 * 4 + e > j) ? cv[q4][e] : 0;
            cst = n > 0 ? ATT_SC + ATT_CC * ((n + BLK - 1) / BLK) : 0; }
        int v = cst;
#pragma unroll
        for (int o_ = 1; o_ < 64; o_ <<= 1) { const int u_ = __shfl_up(v, o_); if (lane >= o_) v += u_; }
        if (lane == 63) wsum[wid] = v;
        __syncthreads();
        int add = 0;
#pragma unroll
        for (int w_ = 0; w_ < 8; ++w_) add += (w_ < wid) ? wsum[w_] : 0;
        if (C.tid < NSEG) segp[C.tid + 1] = v + add; if (C.tid == 0) segp[0] = 0;
        __syncthreads();
    }
    const long W = segp[NSEG];
    const int clo = (int)(W * C.vcu / C.G), chi = (int)(W * (C.vcu + 1) / C.G);
    int t_first;
    { const bool below = C.tid < NSEG && segp[C.tid + 1] <= clo; const int cnt = __popcll(__ballot(below));
      if (lane == 0) wsum[8 + wid] = cnt;
      __syncthreads();
      t_first = 0;
#pragma unroll
      for (int w_ = 0; w_ < 8; ++w_) t_first += wsum[8 + w_]; }
    LAS int* prefw = (LAS int*)(C.lds + L_PREF + 2560) + wid * 72;
    auto next_piece = [&](int t, int& pt, int& c_lo, int& c_hi, int& k) -> bool {
        for (; t < NSEG; ++t) {
            const int s0 = segp[t]; if (s0 >= chi) return false;
            const int s1 = segp[t + 1];
            if (s1 <= clo || s1 == s0) continue;
            k = (s1 - s0 - ATT_SC) / ATT_CC;
            c_lo = 0; if (clo > s0) { c_lo = (clo - s0 - ATT_SC + ATT_CC - 1) / ATT_CC; if (c_lo < 1) c_lo = 1; }
            c_hi = k; if (chi < s1) { c_hi = (chi > s0) ? ((chi - s0 - ATT_SC + ATT_CC - 1) / ATT_CC) : 0; if (chi > s0 && c_hi < 1) c_hi = 1; if (c_hi > k) c_hi = k; }
            if (c_hi <= c_lo) continue;
            pt = t; return true; }
        return false; };
    auto cnt_load = [&](int t) -> int { const int j = t >> 4, h = t & 15; const int ln = lane & 31; return CNT[(h * NBLK + j) * NBLK + ln]; };
    auto pref_finish = [&](int t, int creg, LAS int* dst) { const int j = t >> 4; int c = (lane > j && lane < NBLK) ? creg : 0;
#pragma unroll
        for (int o_ = 1; o_ < 64; o_ <<= 1) { const int v = __shfl_up(c, o_); if (lane >= o_) c += v; }
        if (lane < NBLK) dst[lane + 1] = c; if (lane == 0) dst[0] = 0; };
    auto lookup = [&](const LAS int* pref, int t, int n, int k, int cc, bool& OK, int& E, int& BS, bool& VALID) {
        const int j = t >> 4, h = t & 15; const unsigned short* lst = LIST + (size_t)(h * NBLK + j) * NBLK * BLK;
        const int rb_ = (int)((long)cc * n / k), re_ = (int)((long)(cc + 1) * n / k); const int g0_ = rb_ + wid * 32;
        OK = g0_ < re_; VALID = false;
        if (OK) { const int g_ = g0_ + r32; VALID = g_ < re_; const int gg_ = VALID ? g_ : g0_;
            int lo_ = j + 1, hi_ = NBLK - 1;
#pragma unroll
            for (int it_ = 0; it_ < 5; ++it_) { const int mid_ = (lo_ + hi_ + 1) >> 1; const bool ge_ = gg_ >= pref[mid_]; lo_ = ge_ ? mid_ : lo_; hi_ = ge_ ? hi_ : mid_ - 1; }
            E = lst[(size_t)lo_ * BLK + (gg_ - pref[lo_])]; BS = lo_; } };
    int pt = 0, c_lo = 0, c_hi = 0, k = 1; bool have = next_piece(t_first, pt, c_lo, c_hi, k);
    int cur = 0, n = 0;
    bool ok_c = false, valid = false; int e_c = 0, bs_c = 0;
    bf16x8 qr[8];
    if (have) { const int cr = cnt_load(pt); pref_finish(pt, cr, prefw); n = prefw[NBLK];
        lookup(prefw, pt, n, k, c_lo, ok_c, e_c, bs_c, valid);
        if (ok_c) { const bf16* q0 = P + CQ + (pt & 15) * HD + hi * 8 + (size_t)(bs_c * BLK + (e_c & 255)) * INC;
#pragma unroll
            for (int d0 = 0; d0 < 8; ++d0) qr[d0] = *(const bf16x8*)(q0 + d0 * 16); } }
    while (have) {
        const int j = pt >> 4, h = pt & 15;
        __syncthreads();
        if (!(C.var & 64)) stage_kv(C.lds, P, j, h, C.tid);
        int nt = 0, nc_lo = 0, nc_hi = 0, nk = 1; const bool have_n = next_piece(pt + 1, nt, nc_lo, nc_hi, nk);
        const int creg_n = have_n ? cnt_load(nt) : 0;
        int n_n = 0;
        __syncthreads();
        const float sl2 = exp2f(-0.5f * (float)(h + 1)) * LOG2E;
        LAS int* pref = prefw + cur * 36;
        for (int c = c_lo; c < c_hi; ++c) {
            bool ok_n = false, valid_n = false; int e_n = 0, bs_n = 0; const bf16* nqb = P;
            if (c + 1 < c_hi) { lookup(pref, pt, n, k, c + 1, ok_n, e_n, bs_n, valid_n); nqb = P + CQ + h * HD + hi * 8 + (size_t)(bs_n * BLK) * INC; }
            else if (have_n) { LAS int* prefn = prefw + (cur ^ 1) * 36; pref_finish(nt, creg_n, prefn); n_n = prefn[NBLK];
                lookup(prefn, nt, n_n, nk, nc_lo, ok_n, e_n, bs_n, valid_n); nqb = P + CQ + (nt & 15) * HD + hi * 8 + (size_t)(bs_n * BLK) * INC; }
            if (ok_c) {
                const int tq = bs_c * BLK + (e_c & 255), slot = e_c >> 8;
                float l_reg = 0.f; f32x16 o[4] = {};
                block_pass<false>(4, C.lds, vb0, qr, ok_n ? nqb : nullptr, e_n, j * BLK, tq, sl2, ref, r32, hi, 0, l_reg, o, C.var);
                { auto rr = __builtin_amdgcn_permlane32_swap(__float_as_uint(l_reg), __float_as_uint(l_reg), false, false); l_reg = __uint_as_float(rr[0]) + __uint_as_float(rr[1]); }
                const int pidx = (tq * NH + h) * 3 + slot;
                if (hi == 0) { rd_l[r32] = (valid && !(C.var & 1)) ? pidx : -1; if (valid && !(C.var & 1)) ML[pidx] = l_reg; }
                asm volatile("s_waitcnt lgkmcnt(0)" ::: "memory");
#pragma unroll
                for (int d0 = 0; d0 < 4; ++d0) {
#pragma unroll
                    for (int r = 0; r < 16; ++r) *(LAS unsigned short*)(ost + crow(r, hi) * 64 + r32 * 2) = (unsigned short)cvtpk(o[d0][r], 0.f);
                    asm volatile("s_waitcnt lgkmcnt(0)" ::: "memory");
#pragma unroll
                    for (int i = 0; i < 2; ++i) { const int pc = lane + 64 * i, row = pc >> 2, chk = pc & 3; const int pd = rd_l[row]; const v4u vv = *(const LAS v4u*)(ost + row * 64 + chk * 16);
                        if (pd >= 0) *(v4u*)(PO + (size_t)pd * HD + d0 * 32 + chk * 8) = vv; }
                    asm volatile("s_waitcnt lgkmcnt(0)" ::: "memory"); }
            } else if (ok_n) { const bf16* q0 = nqb + (size_t)(e_n & 255) * INC;
#pragma unroll
                for (int d0 = 0; d0 < 8; ++d0) qr[d0] = *(const bf16x8*)(q0 + d0 * 16); }
            ok_c = ok_n; e_c = e_n; bs_c = bs_n; valid = valid_n;
        }
        if (have_n && c_hi <= c_lo) { }
        cur ^= 1; pt = nt; c_lo = nc_lo; c_hi = nc_hi; k = nk; n = n_n; have = have_n;
    }
    __builtin_amdgcn_s_setprio(0);
}

__device__ __forceinline__ void phase_atto(const Ctx& C) {
    using namespace att;
    const bf16* P = (const bf16*)(C.ws + WS_P); const bf16* PO = (const bf16*)(C.ws + WS_PO); const float* ML = (const float*)(C.ws + WS_ML); bf16* AL = (bf16*)(C.ws + WS_AL);
    const int lane = C.lane, r32 = lane & 31, hi = lane >> 5, wid = C.wave;
    const int* SELJ = (const int*)(C.ws + WS_SELJ); const float qkb = att_qkb(C.in[I_QNW], C.in[I_KNW], lane);
    const float ref = att_ref(C.in[I_QNW], C.in[I_KNW], lane);
    const int vb0 = (int)(uintptr_t)(C.lds + L_V) + v_rd_base(lane);
    if (__builtin_amdgcn_readfirstlane(threadIdx.x) >= 256) __builtin_amdgcn_s_setprio(1);
    for (int item = C.vcu; item < NH * NBLK; item += C.G) {
        const int h = item & 15, b = item >> 4;
        const int qloc = wid * 32 + r32, t = b * BLK + qloc;
        bf16x8 qr[8];
#pragma unroll
        for (int d0 = 0; d0 < 8; ++d0) qr[d0] = *(const bf16x8*)(P + (size_t)t * INC + CQ + h * HD + d0 * 16 + hi * 8);
        __syncthreads();
        if (!(C.var & 64)) stage_kv(C.lds, P, b, h, C.tid);
        __syncthreads();
        const float sl2 = exp2f(-0.5f * (float)(h + 1)) * LOG2E;
        float l_reg = 0.f; f32x16 o[4] = {};
        block_pass<true>((wid >> 1) + 1, C.lds, vb0, qr, nullptr, 0, b * BLK, t, sl2, ref, r32, hi, qloc, l_reg, o, C.var);
        { auto rr = __builtin_amdgcn_permlane32_swap(__float_as_uint(l_reg), __float_as_uint(l_reg), false, false); l_reg = __uint_as_float(rr[0]) + __uint_as_float(rr[1]); }
        int lane2 = lane; asm volatile("" : "+v"(lane2));
        const int r32b = lane2 & 31, hib = lane2 >> 5; const int tb2 = b * BLK + wid * 32 + r32b;
        LAS float* mw = (LAS float*)(C.lds + L_WS) + wid * 128; LAS float* orow = (LAS float*)(C.lds + wid * 16384);
        const int nsel = b < 3 ? b : 3;
        float den = l_reg;
        { const int sj = SELJ[tb2 * NH + h]; const float* mlp = ML + (size_t)(tb2 * NH + h) * 3; const float l0 = mlp[0], l1 = mlp[1], l2 = mlp[2];
          den += (0 < nsel && att_live(h, b - (sj & 255), qkb)) ? l0 : 0.f; den += (1 < nsel && att_live(h, b - ((sj >> 8) & 255), qkb)) ? l1 : 0.f; den += (2 < nsel && att_live(h, b - ((sj >> 16) & 255), qkb)) ? l2 : 0.f; }
        if (hib == 0) mw[r32b] = 1.0f / den;
        const int trm = b * BLK + wid * 32 + (lane2 >> 2); const int sjr0 = SELJ[trm * NH + h], sjr1 = SELJ[(trm + 16) * NH + h];
        __syncthreads();
#pragma unroll
        for (int r = 0; r < 16; ++r) { const int row = crow(r, hib);
#pragma unroll
            for (int d0 = 0; d0 < 4; ++d0) orow[row * 128 + ((d0 * 32 + r32b) ^ ((row & 7) << 2))] = o[d0][r]; }
        asm volatile("s_waitcnt lgkmcnt(0)" ::: "memory");
#pragma unroll 1
        for (int pass = (C.var & 128) ? 2 : 0; pass < 2; ++pass) {
            const int row = pass * 16 + (lane2 >> 2), ch = (lane2 & 3) * 32, trow = b * BLK + wid * 32 + row;
            const float a0 = mw[row];
            float acc[32];
#pragma unroll
            for (int c4 = 0; c4 < 8; ++c4) { const f32x4 v = *(const LAS f32x4*)(orow + row * 128 + ((ch + c4 * 4) ^ ((row & 7) << 2)));
                acc[c4 * 4 + 0] = v[0]; acc[c4 * 4 + 1] = v[1]; acc[c4 * 4 + 2] = v[2]; acc[c4 * 4 + 3] = v[3]; }
            const int sjr = pass ? sjr1 : sjr0;
            v4u pv8[3][4];
#pragma unroll
            for (int s = 0; s < 3; ++s) { const bool on = s < nsel && att_live(h, b - ((sjr >> (8 * s)) & 255), qkb);
                const v4u* po = (const v4u*)(on ? PO + (size_t)((trow * NH + h) * 3 + s) * HD + ch : PO + ch);
#pragma unroll
                for (int c8 = 0; c8 < 4; ++c8) pv8[s][c8] = po[c8]; }
#pragma unroll
            for (int s = 0; s < 3; ++s) { const bool on = s < nsel && att_live(h, b - ((sjr >> (8 * s)) & 255), qkb);
#pragma unroll
                for (int c8 = 0; c8 < 4; ++c8) { const unsigned w4[4] = {pv8[s][c8].x, pv8[s][c8].y, pv8[s][c8].z, pv8[s][c8].w};
#pragma unroll
                    for (int e = 0; e < 4; ++e) { acc[c8 * 8 + 2 * e] += on ? bflo(w4[e]) : 0.f; acc[c8 * 8 + 2 * e + 1] += on ? bfhi(w4[e]) : 0.f; } } }
#pragma unroll
            for (int i = 0; i < 32; ++i) acc[i] *= a0;
            v4u* dst = (v4u*)(AL + (size_t)trow * 4096 + h * HD + ch);
#pragma unroll
            for (int c8 = 0; c8 < 4; ++c8) { v4u w; w.x = cvtpk(acc[c8 * 8], acc[c8 * 8 + 1]); w.y = cvtpk(acc[c8 * 8 + 2], acc[c8 * 8 + 3]); w.z = cvtpk(acc[c8 * 8 + 4], acc[c8 * 8 + 5]); w.w = cvtpk(acc[c8 * 8 + 6], acc[c8 * 8 + 7]); dst[c8] = w; }
        }
    }
    __builtin_amdgcn_s_setprio(0);
}

#define XB_TMO      128
#define XB_XCNT(j)  (256  + 64 * (j))
#define XB_XSUB(j)  (1280 + 64 * (j))
#define XB_XGEN(j)  (2304 + 64 * (j))
#define XB_TOP      3328
#define XB_TOPGEN   3392
#define XCD_BAR_WORDS 3456
#define XB_SPIN_CAP (1u << 18)
__device__ __forceinline__ unsigned xb_ld(unsigned* p)              { return __hip_atomic_load(p, __ATOMIC_RELAXED, __HIP_MEMORY_SCOPE_AGENT); }
__device__ __forceinline__ unsigned xb_add(unsigned* p, unsigned v) { return __hip_atomic_fetch_add(p, v, __ATOMIC_RELAXED, __HIP_MEMORY_SCOPE_AGENT); }
__device__ __forceinline__ unsigned xb_xcc_id() { return (unsigned)__builtin_amdgcn_s_getreg((3 << 11) | 20) & 0xFu; }
#define XB_SPIN(cond, bar) do { unsigned _sp = 0; while (cond) { __builtin_amdgcn_s_sleep(1); \
    if ((++_sp & 255u) == 0u) { if (xb_ld(&(bar)[XB_TMO])) break; if (_sp > XB_SPIN_CAP) { atomicAdd(&(bar)[XB_TMO], 1u); break; } } } } while (0)
struct XcdBarrier { unsigned* bar; unsigned x; volatile LAS unsigned* st; };
__device__ __forceinline__ XcdBarrier xcd_barrier_post(unsigned* bar, volatile LAS unsigned* st) {
    XcdBarrier b; b.bar = bar; b.x = xb_xcc_id(); b.st = st;
    if (threadIdx.x == 0) (void)xb_add(&bar[XB_XCNT(b.x)], 1u);
    return b;
}
__device__ __forceinline__ void xcd_barrier_complete(unsigned* bar, unsigned x, unsigned& nloc, unsigned& nx) {
    const unsigned G = gridDim.x * gridDim.y * gridDim.z;
    unsigned sum, cnt, mine, sp = 0u;
    for (;;) {
        sum = 0u; cnt = 0u; mine = 0u;
#pragma unroll
        for (unsigned j = 0; j < 16; ++j) { const unsigned c = xb_ld(&bar[XB_XCNT(j)]); sum += c; cnt += (c > 0u) ? 1u : 0u; mine = (j == x) ? c : mine; }
        if (sum == G) break;
        __builtin_amdgcn_s_sleep(1);
        if ((++sp & 255u) == 0u) { if (xb_ld(&bar[XB_TMO])) break; if (sp > XB_SPIN_CAP) { atomicAdd(&bar[XB_TMO], 1u); break; } }
    }
    nloc = mine > 0u ? mine : 1u; nx = cnt > 0u ? cnt : 1u;
}
__device__ __forceinline__ void xcd_barrier(const XcdBarrier& b) {
    asm volatile("s_waitcnt vmcnt(0)" ::: "memory");
    __syncthreads();
    if (threadIdx.x == 0) {
        unsigned* bar = b.bar;
        __builtin_amdgcn_s_waitcnt(0);
        unsigned nloc = b.st[0], nx = b.st[1];
        if (nloc == 0u) { xcd_barrier_complete(bar, b.x, nloc, nx); b.st[0] = nloc; b.st[1] = nx; }
        const unsigned old = xb_add(&bar[XB_XSUB(b.x)], 1u);
        const unsigned gen = old / nloc;
        if (old + 1u == (gen + 1u) * nloc) {
            __builtin_amdgcn_fence(__ATOMIC_RELEASE, "agent");
            asm volatile("s_waitcnt vmcnt(0)" ::: "memory");
            const unsigned og = xb_add(&bar[XB_TOP], 1u);
            const unsigned tg = og / nx;
            if (og + 1u == (tg + 1u) * nx) xb_add(&bar[XB_TOPGEN], 1u);
            else XB_SPIN(xb_ld(&bar[XB_TOPGEN]) == tg, bar);
            __builtin_amdgcn_fence(__ATOMIC_ACQUIRE, "agent");
            xb_add(&bar[XB_XGEN(b.x)], 1u);
            asm volatile("s_waitcnt vmcnt(0)" ::: "memory");
        } else {
            XB_SPIN(xb_ld(&bar[XB_XGEN(b.x)]) == gen, bar);
            __builtin_amdgcn_fence(__ATOMIC_ACQUIRE, "agent");
            asm volatile("s_waitcnt vmcnt(0)" ::: "memory");
        }
    }
    __syncthreads();
}
constexpr int MISC_OFF = 163584;
constexpr int CW_BAR = 4096;
constexpr int RST_OFF = 131072 + 10240, WTAB_OFF = RST_OFF + 8 * 1024;

enum { PH_PREPA = 0, PH_GEMM1, PH_SEL_LRUA, PH_ATTP_LRUB, PH_ATTO, PH_PROJ, PH_OUT_PREPB, PH_UP, PH_DOWN, PH_N };
__global__ void __launch_bounds__(NTHR, 2) mk(Args args) {
    extern __shared__ __attribute__((aligned(16))) unsigned char lds_raw[];
    Ctx C; C.lds = (LAS unsigned char*)lds_raw; C.tid = threadIdx.x; C.lane = C.tid & 63; C.wave = __builtin_amdgcn_readfirstlane(C.tid >> 6);
    C.G = gridDim.x; { const int bx = blockIdx.x; C.vcu = (C.G % 8 == 0) ? (bx % 8) * (C.G / 8) + bx / 8 : bx; }
    C.in = args.in; C.out = args.out; C.ws = args.ws; C.var = args.var;
    const int lo = args.ph_lo, hi = args.ph_hi;
    volatile LAS unsigned* MISC = (volatile LAS unsigned*)(C.lds + MISC_OFF);
    if (C.tid < 32) MISC[C.tid] = 0u;
    __syncthreads();
    XcdBarrier bar; bar.bar = (unsigned*)(C.ws + WS_CTL) + CW_BAR; bar.x = 0; bar.st = nullptr;
    if (hi - lo > 1) bar = xcd_barrier_post((unsigned*)(C.ws + WS_CTL) + CW_BAR, MISC);
#define SEAM(k) do { if (IN(k) && IN((k) + 1)) xcd_barrier(bar); } while (0)
#ifndef PHMASK
#define PHMASK 0x1ff
#endif
#define IN(k) (((PHMASK >> (k)) & 1) && lo <= (k) && (k) < hi)
#define NREP(k) ((PROBE_REP == (k)) ? 2 : 1)
    if (IN(PH_PREPA)) for (int rep = 0; rep < NREP(PH_PREPA); ++rep) { phase_prepA(C); __syncthreads(); }
    SEAM(PH_PREPA);
    if (IN(PH_GEMM1)) { pg8::Gemm g{(const bf16*)(C.ws + WS_XB), (const bf16*)(C.ws + WS_WIN), DM, DM, S, INC, DM}; pg8::StaticOrder So; So.init(S, INC, C.G, (int)blockIdx.x);
        LAS float* rst = (LAS float*)(C.lds + RST_OFF); LAS float* wtab = (LAS float*)(C.lds + WTAB_OFF);
        { pg8::Unit uu; const float* R1 = (const float*)(C.ws + WS_RSTD1);
#pragma unroll
          for (int e = 0; e < 4; ++e) { const int idx = C.tid + e * NTHR, i = idx >> 8; const bool ok = So.next(i, uu); const float v = R1[(ok ? uu.pm : 0) * 256 + (idx & 255)]; if (ok) rst[idx] = v; }
          if (C.tid < 128) wtab[C.tid] = C.in[I_QNW][C.tid] * QSCALE_; else if (C.tid < 256) wtab[C.tid] = C.in[I_KNW][C.tid - 128];
          __syncthreads(); }
        pg8::EpiP E{(bf16*)(C.ws + WS_P), rst, wtab, (float*)(C.ws + WS_KMEAN), (LAS float*)(C.lds + 131072)}; pg8::gemm_phase<pg8::EpiP, true>(C.lds, g, So, E); }
    SEAM(PH_GEMM1);
    if (IN(PH_SEL_LRUA)) { for (int rep = 0; rep < NREP(PH_SEL_LRUA); ++rep) { phase_select(C); __syncthreads(); } for (int rep = 0; rep < NREP(10); ++rep) { phase_lru_a(C); __syncthreads(); } }
    SEAM(PH_SEL_LRUA);
    if (IN(PH_ATTP_LRUB)) { if (!(C.var & 2)) { phase_lru_b(C); __syncthreads(); } for (int rep = 0; rep < NREP(PH_ATTP_LRUB); ++rep) { if (!(C.var & 4)) phase_attp(C); __syncthreads(); } }
    SEAM(PH_ATTP_LRUB);
    if (IN(PH_ATTO)) for (int rep = 0; rep < NREP(PH_ATTO); ++rep) { phase_atto(C); __syncthreads(); }
    SEAM(PH_ATTO);
    if (IN(PH_PROJ)) { pg8::Gemm g{(const bf16*)(C.ws + WS_AL), (const bf16*)(C.ws + WS_WP), 2 * DM, 2 * DM, S, DM, 2 * DM}; pg8::StaticOrder So; So.init(S, DM, C.G, (int)blockIdx.x);
        pg8::EpiMrg E{(const bf16*)(C.ws + WS_P), (bf16*)(C.ws + WS_MRG)}; pg8::gemm_phase<pg8::EpiMrg, false>(C.lds, g, So, E); }
    SEAM(PH_PROJ);
    if (IN(PH_OUT_PREPB)) { pg8::Gemm g{(const bf16*)(C.ws + WS_MRG), (const bf16*)(C.ws + WS_WO), DM, DM, S, DM, DM}; pg8::StaticOrder So; So.init(S, DM, C.G, (int)blockIdx.x);
        pg8::EpiX1 E{C.in[I_X], C.out, (bf16*)(C.ws + WS_X1B), (float*)(C.ws + WS_SSQ)}; pg8::gemm_phase<pg8::EpiX1, false>(C.lds, g, So, E);
        for (int rep = 0; rep < NREP(PH_OUT_PREPB); ++rep) { __syncthreads(); phase_prepB_gu(C); } }
    SEAM(PH_OUT_PREPB);
    if (IN(PH_UP)) { pg8::Gemm g{(const bf16*)(C.ws + WS_X1B), (const bf16*)(C.ws + WS_WGU), DM, DM, S, 2 * DFF, DM}; pg8::StaticOrder So; So.init(S, 2 * DFF, C.G, (int)blockIdx.x);
        LAS float* rst = (LAS float*)(C.lds + RST_OFF);
        { pg8::Unit uu; const float* SSQ = (const float*)(C.ws + WS_SSQ);
          f32x4 sv[4][8]; bool okv[4];
#pragma unroll
          for (int e = 0; e < 4; ++e) { const int idx = C.tid + e * NTHR, i = idx >> 8; okv[e] = So.next(i, uu); const f32x4* sp = (const f32x4*)(SSQ + (size_t)((okv[e] ? uu.pm : 0) * 256 + (idx & 255)) * 32);
#pragma unroll
              for (int k = 0; k < 8; ++k) sv[e][k] = sp[k]; }
#pragma unroll
          for (int e = 0; e < 4; ++e) { float s = 0.f;
#pragma unroll
              for (int k = 0; k < 8; ++k) s += (sv[e][k][0] + sv[e][k][1]) + (sv[e][k][2] + sv[e][k][3]);
              if (okv[e]) rst[C.tid + e * NTHR] = __builtin_amdgcn_rsqf(s * (1.f / DM) + EPS); }
          __syncthreads(); }
        pg8::EpiAct E{rst, (bf16*)(C.ws + WS_ACT)}; pg8::gemm_phase<pg8::EpiAct, true>(C.lds, g, So, E);
        { const int nwg = (S / 256) * (2 * DFF / 256), full = nwg / C.G, rem = nwg - full * C.G;
          __syncthreads();
          if (rem == 0) phase_prepB_d(C, (int)blockIdx.x, C.G); else if ((int)blockIdx.x >= rem) phase_prepB_d(C, (int)blockIdx.x - rem, C.G - rem); } }
    SEAM(PH_UP);
    if (IN(PH_DOWN)) { pg8::Gemm g{(const bf16*)(C.ws + WS_ACT), (const bf16*)(C.ws + WS_WD), DFF, DFF, S, DM, DFF}; pg8::StaticOrder So; So.init(S, DM, C.G, (int)blockIdx.x);
        pg8::EpiOut E{(const bf16*)(C.ws + WS_X1B), C.out}; pg8::gemm_phase<pg8::EpiOut, false>(C.lds, g, So, E); }
#if PROBE_REP == 200
    if (lo == PH_N + 0) { pg8::Gemm g{(const bf16*)(C.ws + WS_X1B), (const bf16*)(C.ws + WS_WGU), DM, DM, S, 2 * DFF, DM}; pg8::StaticOrder So; So.init(S, 2 * DFF, C.G, (int)blockIdx.x);
        pg8::EpiNull E{}; pg8::gemm_phase<pg8::EpiNull, true>(C.lds, g, So, E); }
#elif PROBE_REP == 204
    if (lo == PH_N + 4) { pg8::Gemm g{(const bf16*)(C.ws + WS_XB), (const bf16*)(C.ws + WS_WIN), DM, DM, S, INC, DM}; pg8::StaticOrder So; So.init(S, INC, C.G, (int)blockIdx.x);
        pg8::EpiNull E{}; pg8::gemm_phase<pg8::EpiNull, true>(C.lds, g, So, E); }
#elif PROBE_REP == 201
    if (lo == PH_N + 1) { pg8::Gemm g{(const bf16*)(C.ws + WS_ACT), (const bf16*)(C.ws + WS_WD), DFF, DFF, S, DM, DFF}; pg8::StaticOrder So; So.init(S, DM, C.G, (int)blockIdx.x);
        pg8::EpiNull E{}; pg8::gemm_phase<pg8::EpiNull, false>(C.lds, g, So, E); }
#elif PROBE_REP == 202
    if (lo == PH_N + 2) { pg8::Gemm g{(const bf16*)(C.ws + WS_MRG), (const bf16*)(C.ws + WS_WO), DM, DM, S, DM, DM}; pg8::StaticOrder So; So.init(S, DM, C.G, (int)blockIdx.x);
        pg8::EpiX1 E{C.in[I_X], (float*)(C.ws + WS_PO), (bf16*)(C.ws + WS_PO + 64 * MiB), (float*)(C.ws + WS_ML)}; pg8::gemm_phase<pg8::EpiX1, false>(C.lds, g, So, E); }
#elif PROBE_REP == 203
    if (lo == PH_N + 3) { pg8::Gemm g{(const bf16*)(C.ws + WS_ACT), (const bf16*)(C.ws + WS_WD), DFF, DFF, S, DM, DFF}; pg8::StaticOrder So; So.init(S, DM, C.G, (int)blockIdx.x);
        pg8::EpiOut E{(const bf16*)(C.ws + WS_X1B), (float*)(C.ws + WS_PO)}; pg8::gemm_phase<pg8::EpiOut, false>(C.lds, g, So, E); }
#endif
#undef IN
#undef SEAM
}

template <class Epi, bool MAPGU>
__global__ void __launch_bounds__(256) naive_gemm(const bf16* A0, const bf16* A1, int lda, const bf16* B0, const bf16* B1, int ldb, int K0, int K1, Epi epi) {
    __shared__ float As[32][68]; __shared__ float Bs[32][68];
    const int tid = threadIdx.x, tx = tid & 15, ty = tid >> 4;
    const int r0 = blockIdx.y * 64, n0 = blockIdx.x * 64;
    const size_t brow0 = MAPGU ? (size_t)(n0 >> 7) * 256 + (n0 & 127) : (size_t)n0;
    float acc[2][4][4];
#pragma unroll
    for (int p = 0; p < 2; ++p)
#pragma unroll
        for (int i = 0; i < 4; ++i)
#pragma unroll
            for (int j = 0; j < 4; ++j) acc[p][i][j] = 0.f;
    const int lr = tid >> 2, lk = (tid & 3) * 8;
#pragma unroll
    for (int p = 0; p < 2; ++p) {
        const bf16* A = p ? A1 : A0; const bf16* B = p ? B1 : B0; const int K = p ? K1 : K0;
        for (int k0 = 0; k0 < K; k0 += 32) {
            const v4u av = *(const v4u*)(A + (size_t)(r0 + lr) * lda + k0 + lk);
            const v4u bv = *(const v4u*)(B + (brow0 + lr) * (size_t)ldb + k0 + lk);
            __syncthreads();
            As[lk + 0][lr] = bflo(av.x); As[lk + 1][lr] = bfhi(av.x); As[lk + 2][lr] = bflo(av.y); As[lk + 3][lr] = bfhi(av.y);
            As[lk + 4][lr] = bflo(av.z); As[lk + 5][lr] = bfhi(av.z); As[lk + 6][lr] = bflo(av.w); As[lk + 7][lr] = bfhi(av.w);
            Bs[lk + 0][lr] = bflo(bv.x); Bs[lk + 1][lr] = bfhi(bv.x); Bs[lk + 2][lr] = bflo(bv.y); Bs[lk + 3][lr] = bfhi(bv.y);
            Bs[lk + 4][lr] = bflo(bv.z); Bs[lk + 5][lr] = bfhi(bv.z); Bs[lk + 6][lr] = bflo(bv.w); Bs[lk + 7][lr] = bfhi(bv.w);
            __syncthreads();
#pragma unroll 8
            for (int k = 0; k < 32; ++k) { const f32x4 a = *(const f32x4*)&As[k][ty * 4], b = *(const f32x4*)&Bs[k][tx * 4];
#pragma unroll
                for (int i = 0; i < 4; ++i)
#pragma unroll
                    for (int j = 0; j < 4; ++j) acc[p][i][j] += a[i] * b[j]; }
        }
    }
#pragma unroll
    for (int i = 0; i < 4; ++i)
#pragma unroll
        for (int j = 0; j < 4; ++j) epi(r0 + ty * 4 + i, n0 + tx * 4 + j, acc[0][i][j], acc[1][i][j]);
}
struct NE1 { const float* rstd1; bf16* P; __device__ void operator()(int r, int c, float a0, float) const { P[(size_t)r * INC + c] = (bf16)f2bf(a0 * rstd1[r]); } };
struct NE6 { const bf16* P; bf16* mrg; __device__ void operator()(int r, int c, float a0, float a1) const {
    const float ga = bf2f(P[(size_t)r * INC + CGA + c]), gl = bf2f(P[(size_t)r * INC + CGL + c]); mrg[(size_t)r * DM + c] = (bf16)f2bf(sigmoidf_(ga) * a0 + sigmoidf_(gl) * a1); } };
struct NE7 { const float* x; float* out; bf16* x1b; __device__ void operator()(int r, int c, float a0, float) const {
    const float v = x[(size_t)r * DM + c] + a0; out[(size_t)r * DM + c] = v; x1b[(size_t)r * DM + c] = (bf16)f2bf(v); } };
struct NE8 { const float* ssq; bf16* act; __device__ void operator()(int r, int c, float a0, float a1) const {
    float s = 0.f; for (int i = 0; i < 32; ++i) s += ssq[r * 32 + i]; const float rs = 1.0f / sqrtf(s * (1.f / DM) + EPS);
    const float g = a0 * rs, u = a1 * rs; act[(size_t)r * DFF + c] = (bf16)f2bf(g * sigmoidf_(g) * u); } };
struct NE9 { float* out; __device__ void operator()(int r, int c, float a0, float) const { out[(size_t)r * DM + c] += a0; } };

__global__ void __launch_bounds__(256) naive_rowssq(const float* x1, float* ssq) {
    const int row = blockIdx.x * 4 + (threadIdx.x >> 6), lane = threadIdx.x & 63;
    float s = 0.f; for (int i = lane; i < DM; i += 64) { const float v = x1[(size_t)row * DM + i]; s += v * v; }
    s = wave_sum(s); if (lane < 32) ssq[row * 32 + lane] = lane == 0 ? s : 0.f;
}

__global__ void __launch_bounds__(256) naive_attn(const bf16* P, const int* SELJ, bf16* AL) {
    __shared__ float qs[128]; __shared__ float sc[1024]; __shared__ float red[4]; __shared__ float part[2][128];
    const int tid = threadIdx.x, t = blockIdx.x >> 4, h = blockIdx.x & 15, b = t >> 8, nsel = b < 3 ? b : 3;
    const int sj = SELJ[t * NH + h];
    if (tid < 128) qs[tid] = bf2f(P[(size_t)t * INC + CQ + h * HD + tid]);
    __syncthreads();
    const float slope = exp2f(-0.5f * (float)(h + 1));
    float val[4]; float mx = -INFINITY;
#pragma unroll
    for (int s = 0; s < 4; ++s) {
        int key; bool ok;
        if (s < 3) { key = ((sj >> (8 * s)) & 255) * BLK + tid; ok = s < nsel; } else { key = b * BLK + tid; ok = key <= t; }
        float v = -INFINITY;
        if (ok) { const v4u* kr = (const v4u*)(P + (size_t)key * INC + CK + h * HD); float dsum = 0.f;
#pragma unroll
            for (int ch = 0; ch < 16; ++ch) { const v4u kv = kr[ch]; const int d = ch * 8;
                dsum += bflo(kv.x) * qs[d] + bfhi(kv.x) * qs[d + 1] + bflo(kv.y) * qs[d + 2] + bfhi(kv.y) * qs[d + 3]
                      + bflo(kv.z) * qs[d + 4] + bfhi(kv.z) * qs[d + 5] + bflo(kv.w) * qs[d + 6] + bfhi(kv.w) * qs[d + 7]; }
            v = dsum - slope * 1.4426950408889634f * (float)(t - key); }
        val[s] = v; mx = fmaxf(mx, v);
    }
#pragma unroll
    for (int o = 1; o < 64; o <<= 1) mx = fmaxf(mx, __shfl_xor(mx, o));
    if ((tid & 63) == 0) red[tid >> 6] = mx;
    __syncthreads();
    mx = fmaxf(fmaxf(red[0], red[1]), fmaxf(red[2], red[3]));
    __syncthreads();
    float ls = 0.f;
#pragma unroll
    for (int s = 0; s < 4; ++s) { const float p = (val[s] == -INFINITY) ? 0.f : exp2f(val[s] - mx); sc[s * 256 + tid] = p; ls += p; }
    ls = wave_sum(ls);
    if ((tid & 63) == 0) red[tid >> 6] = ls;
    __syncthreads();
    const float l = (red[0] + red[1]) + (red[2] + red[3]);
    const int d = tid & 127, half = tid >> 7; float acc = 0.f;
    for (int s = half * 2; s < half * 2 + 2; ++s) {
        const int base = (s < 3) ? ((sj >> (8 * s)) & 255) * BLK : b * BLK;
        if (s < 3 && s >= nsel) continue;
        for (int i = 0; i < 256; ++i) { const float p = sc[s * 256 + i]; if (p != 0.f) acc += p * bf2f(P[(size_t)(base + i) * INC + CV + h * HD + d]); }
    }
    part[half][d] = acc;
    __syncthreads();
    if (tid < 128) AL[(size_t)t * 4096 + h * HD + tid] = (bf16)f2bf((part[0][tid] + part[1][tid]) / l);
}

static void launch_mk(const Args& base, int lo, int hi, int grid, hipStream_t stream) {
    Args a = base; a.ph_lo = lo; a.ph_hi = hi;
    hipLaunchKernelGGL(mk, dim3(grid), dim3(NTHR), LDS_BYTES, stream, a);
}
extern "C" void kernel_launch(void* const* d_in, const int* in_sizes, int n_in, void* d_out, int out_size, void* d_ws, size_t ws_size, hipStream_t stream) {
    static int grid = 0;
    if (grid == 0) {
        if (n_in != 19 || in_sizes[0] != S * DM || out_size != S * DM || ws_size < WS_END) { fprintf(stderr, "kernel_launch: unexpected shapes (n_in %d, in0 %d, out %d, ws %zu)\n", n_in, n_in > 0 ? in_sizes[0] : -1, out_size, ws_size); grid = -1; return; }
        int dev = 0, cus = 0, per_cu = 0;
        if (hipGetDevice(&dev) != hipSuccess || hipDeviceGetAttribute(&cus, hipDeviceAttributeMultiprocessorCount, dev) != hipSuccess) { grid = -1; return; }
        if (hipFuncSetAttribute((const void*)mk, hipFuncAttributeMaxDynamicSharedMemorySize, LDS_BYTES) != hipSuccess) { fprintf(stderr, "kernel_launch: hipFuncSetAttribute failed\n"); grid = -1; return; }
        if (hipOccupancyMaxActiveBlocksPerMultiprocessor(&per_cu, (const void*)mk, NTHR, LDS_BYTES) != hipSuccess || per_cu < 1) fprintf(stderr, "kernel_launch: occupancy query says %d\n", per_cu);
        (void)hipGetLastError();
        grid = cus;
    }
    if (grid < 0) return;
    unsigned char* ws = (unsigned char*)d_ws;
    Args a{}; for (int i = 0; i < 19; ++i) a.in[i] = (const float*)d_in[i]; a.out = (float*)d_out; a.ws = ws;
#if defined(MK_PER_PHASE)
    for (int ph = 0; ph < PH_N; ++ph) launch_mk(a, ph, ph + 1, grid, stream);
#else
    if (hipMemsetAsync(ws + WS_CTL, 0, 65536, stream) != hipSuccess) { fprintf(stderr, "kernel_launch: memset failed\n"); return; }
    launch_mk(a, 0, PH_N, grid, stream);
#if PROBE_REP >= 200
    launch_mk(a, PH_N + PROBE_REP - 200, PH_N + PROBE_REP - 200 + 1, grid, stream);
#elif PROBE_REP >= 100
    { Args a2 = a; a2.var = PROBE_VAR; launch_mk(a2, PROBE_REP - 100, PROBE_REP - 100 + 1, grid, stream); }
#endif
#endif
}
```

```cpp
#include <hip/hip_runtime.h>
#include <cstdio>
#include <cstdint>
#ifndef PROBE_VAR
#define PROBE_VAR 0
#endif
#ifndef PROBE_REP
#define PROBE_REP -1
#endif

constexpr int S = 8192, DM = 2048, NH = 16, HD = 128, NBLK = 32, BLK = 256;
constexpr int DFF = 5632, NCOL = 14336, INC = 12288;
constexpr int CQ = 0, CK = 2048, CV = 4096, CXR = 6144, CYR = 8192, CGA = 10240, CGL = 12288;
constexpr float EPS = 1e-6f;
constexpr float ATT_SCALE = 0.08838834764831845f;
constexpr float QSCALE_ = ATT_SCALE * 1.4426950408889634f;

constexpr size_t MiB = 1u << 20;
constexpr size_t WS_CTL = 0, CTL_ZERO_BYTES = 1 * MiB;
constexpr size_t WS_RSTD1 = 1 * MiB;
constexpr size_t WS_KMEAN = 1 * MiB + 64 * 1024;
constexpr size_t WS_CNT = 1 * MiB + 384 * 1024;
constexpr size_t WS_LAGG = 1 * MiB + 512 * 1024;
constexpr size_t WS_SELJ = 2 * MiB;
constexpr size_t WS_SSQ = 3 * MiB;
constexpr size_t WS_WRG = 4 * MiB;
constexpr size_t WS_WP = 5 * MiB;
constexpr size_t WS_WO = 21 * MiB;
constexpr size_t WS_WIN = 29 * MiB;
constexpr size_t WS_LIST = 29 * MiB;
constexpr size_t WS_ML = 37 * MiB;
constexpr size_t WS_AL = 40 * MiB;
constexpr size_t WS_XB = 309 * MiB;
constexpr size_t WS_P = 117 * MiB;
constexpr size_t WS_WGU = 117 * MiB;
constexpr size_t WS_WD = 161 * MiB;
constexpr size_t WS_X1B = 183 * MiB;
constexpr size_t WS_ACT = 215 * MiB;
constexpr size_t WS_PO = 341 * MiB;
constexpr size_t WS_LX2 = WS_AL;
constexpr size_t WS_LBX = WS_AL + 2048 * 2;
constexpr size_t WS_MRG = 341 * MiB;
constexpr size_t WS_END = 437 * MiB;

#define GAS __attribute__((address_space(1)))
#define LAS __attribute__((address_space(3)))
typedef unsigned short bf16;
typedef unsigned v4u __attribute__((ext_vector_type(4)));
typedef unsigned v2u __attribute__((ext_vector_type(2)));
typedef float f32x4 __attribute__((ext_vector_type(4)));
__device__ __forceinline__ unsigned f2bf(float f) { unsigned u = __builtin_bit_cast(unsigned, f); return (u + 0x7fffu + ((u >> 16) & 1u)) >> 16; }
__device__ __forceinline__ unsigned pk2(float lo, float hi) { return f2bf(lo) | (f2bf(hi) << 16); }
__device__ __forceinline__ float bf2f(unsigned b) { return __builtin_bit_cast(float, b << 16); }
__device__ __forceinline__ float bflo(unsigned u) { return __builtin_bit_cast(float, u << 16); }
__device__ __forceinline__ float bfhi(unsigned u) { return __builtin_bit_cast(float, u & 0xffff0000u); }
__device__ __forceinline__ float wave_sum(float v) {
#pragma unroll
    for (int o = 1; o < 64; o <<= 1) v += __shfl_xor(v, o);
    return v;
}
__device__ __forceinline__ float sigmoidf_(float x) { return 1.f / (1.f + __expf(-x)); }
__device__ __forceinline__ float gelu_tanh(float x) { const float u = 0.7978845608028654f * (x + 0.044715f * x * x * x); return 0.5f * x * (1.f + tanhf(u)); }

constexpr int NWAVES = 8, NTHR = 512;
constexpr int LDS_BYTES = 163840;

struct Args { const float* in[19]; float* out; unsigned char* ws; int ph_lo, ph_hi, var, pad; };
enum { I_X = 0, I_N1W, I_WIN, I_QNW, I_KNW, I_CONVW, I_CONVB, I_WRGA, I_BRGA, I_WRGX, I_BRGX, I_LAM, I_WPA, I_WPL, I_WOUT, I_N2W, I_WG, I_WU, I_WD };

typedef short s16x4_ __attribute__((ext_vector_type(4)));
struct TrD { const float* W; const float* ks; bf16* WT; size_t drow0; int ldw, k0, n0, ldt, dcol0; };
__device__ __forceinline__ void tr_load(const TrD& d, f32x4 (&v)[16], float (&sc)[16], int lane) {
    const int kr = lane >> 4, nq = lane & 15;
#pragma unroll
    for (int i = 0; i < 16; ++i) v[i] = __builtin_nontemporal_load((const f32x4*)(d.W + (size_t)(d.k0 + 4 * i + kr) * d.ldw + d.n0 + 4 * nq));
    if (d.ks) {
#pragma unroll
        for (int i = 0; i < 16; ++i) sc[i] = d.ks[d.k0 + 4 * i + kr]; }
    else {
#pragma unroll
        for (int i = 0; i < 16; ++i) sc[i] = 1.f; }
}
__device__ __forceinline__ void tr_finish(const TrD& d, const f32x4 (&v)[16], const float (&sc)[16], LAS unsigned char* scr, int lane) {
    const int kr = lane >> 4, nq = lane & 15;
#pragma unroll
    for (int i = 0; i < 16; ++i) { const f32x4 x = v[i] * sc[i]; v2u w; w.x = pk2(x.x, x.y); w.y = pk2(x.z, x.w); *(LAS v2u*)(scr + (4 * i + kr) * 128 + 8 * nq) = w; }
    asm volatile("s_waitcnt lgkmcnt(0)" ::: "memory");
    const int g = lane >> 4, q = (lane >> 2) & 3, p = lane & 3;
    const LAS unsigned char* rb = scr + q * 128 + (16 * g + 4 * p) * 2;
    s16x4_ t[16];
#pragma unroll
    for (int kk = 0; kk < 16; ++kk) t[kk] = __builtin_bit_cast(s16x4_, __builtin_amdgcn_ds_read_tr16_b64_v4i16((LAS s16x4_*)(rb + kk * 512)));
    asm volatile("s_waitcnt lgkmcnt(0)" ::: "memory");
    const int nrow = 16 * g + (lane & 15);
#pragma unroll
    for (int e = 0; e < 8; ++e) { const v2u a = __builtin_bit_cast(v2u, t[2 * e]), b = __builtin_bit_cast(v2u, t[2 * e + 1]); v4u o = {a.x, a.y, b.x, b.y};
        *(LAS v4u*)(scr + nrow * 128 + ((e ^ (nrow & 7)) << 4)) = o; }
    asm volatile("s_waitcnt lgkmcnt(0)" ::: "memory");
    const int rr = lane >> 3, cc = lane & 7;
#pragma unroll
    for (int i = 0; i < 8; ++i) { const int r = rr + 8 * i; const v4u o = *(const LAS v4u*)(scr + r * 128 + ((cc ^ (r & 7)) << 4));
        *(v4u*)(d.WT + (d.drow0 + r) * (size_t)d.ldt + d.dcol0 + d.k0 + 8 * cc) = o; }
    asm volatile("s_waitcnt lgkmcnt(0)" ::: "memory");
}
template <class Dec> __device__ __forceinline__ void tr_stream(int it0, int nit, int stride, const Dec& dec, LAS unsigned char* scr, int lane) {
    if (it0 >= nit) return;
    asm volatile("" : "+v"(lane));
    TrD dA, dB; f32x4 vA[16], vB[16]; float sA[16], sB[16];
    int it = it0; dA = dec(it); tr_load(dA, vA, sA, lane);
    for (;;) {
        const int itB = it + stride; const bool hb = itB < nit; if (hb) { dB = dec(itB); tr_load(dB, vB, sB, lane); }
        tr_finish(dA, vA, sA, scr, lane);
        if (!hb) break;
        it = itB + stride; const bool ha = it < nit; if (ha) { dA = dec(it); tr_load(dA, vA, sA, lane); }
        tr_finish(dB, vB, sB, scr, lane);
        if (!ha) break;
    }
}

struct Ctx {
    LAS unsigned char* lds; int tid, lane, wave, vcu, G, var;
    const float* const* in; float* out; unsigned char* ws;
    float qkb, ref;
};

constexpr int SEL_NCV = 3 * (DM / 64) * (DM / 64);
__device__ __forceinline__ TrD sel_cv_desc(const Ctx& C, int it) {
    constexpr int I_SQ = (DM / 64) * (DM / 64); const int m = it / I_SQ, r = it - m * I_SQ; const int nb = DM / 64, kb = r / nb, n0 = (r % nb) * 64;
    bf16* WP = (bf16*)(C.ws + WS_WP); bf16* WO = (bf16*)(C.ws + WS_WO);
    if (m == 0) return TrD{C.in[I_WPA], nullptr, WP, (size_t)n0, DM, kb * 64, n0, 2 * DM, 0};
    if (m == 1) return TrD{C.in[I_WPL], nullptr, WP, (size_t)n0, DM, kb * 64, n0, 2 * DM, DM};
    return TrD{C.in[I_WOUT], nullptr, WO, (size_t)n0, DM, kb * 64, n0, DM, 0};
}
__device__ __forceinline__ void phase_prepA(const Ctx& C) {
    LAS unsigned char* scr = C.lds + C.wave * 16384;
    const int gw = C.vcu * NWAVES + C.wave, NGW = C.G * NWAVES;
    constexpr int I_IN = (DM / 64) * (NCOL / 64), I_SQ = (DM / 64) * (DM / 64), I_RG = 32 * 4;
    constexpr int NIT = I_IN + I_RG;
    bf16* WIN = (bf16*)(C.ws + WS_WIN); bf16* WP = (bf16*)(C.ws + WS_WP); bf16* WO = (bf16*)(C.ws + WS_WO); bf16* WRG = (bf16*)(C.ws + WS_WRG);
    const float* const* in = C.in;
    auto dec = [=](int it) -> TrD { TrD d; int r = it;
        if (r < I_IN) { const int nb = NCOL / 64, kb = r / nb, n0 = (r % nb) * 64; d = TrD{in[I_WIN], in[I_N1W], WIN, (size_t)n0, NCOL, kb * 64, n0, DM, 0}; return d; } r -= I_IN;
        { const int mat = r >> 2, sub = r & 3, n = mat >> 1, g = mat & 1, k0 = (sub >> 1) * 64, n0 = (sub & 1) * 64;
          const float* W = (g ? in[I_WRGX] : in[I_WRGA]) + (size_t)n * 128 * 128;
          d = TrD{W, nullptr, WRG, (size_t)((n * 2 + g) * 128 + n0), 128, k0, n0, 128, 0}; return d; } };
    tr_stream(gw, NIT, NGW, dec, scr, C.lane);
    bf16* XB = (bf16*)(C.ws + WS_XB); float* RSTD1 = (float*)(C.ws + WS_RSTD1);
    {
        f32x4 va[8], vb[8];
        auto ld = [&](int m, f32x4 (&v)[8]) { const f32x4* xr = (const f32x4*)(C.in[I_X] + (size_t)m * DM) + C.lane;
#pragma unroll
            for (int j = 0; j < 8; ++j) v[j] = __builtin_nontemporal_load(xr + 64 * j); };
        auto fin = [&](int m, const f32x4 (&v)[8]) { float s = 0.f;
#pragma unroll
            for (int j = 0; j < 8; ++j) s += (v[j].x * v[j].x + v[j].y * v[j].y) + (v[j].z * v[j].z + v[j].w * v[j].w);
            s = wave_sum(s);
            if (C.lane == 0) RSTD1[m] = 1.0f / sqrtf(s * (1.f / DM) + EPS);
            v2u* o = (v2u*)(XB + (size_t)m * DM) + C.lane;
#pragma unroll
            for (int j = 0; j < 8; ++j) { v2u w; w.x = pk2(v[j].x, v[j].y); w.y = pk2(v[j].z, v[j].w); o[64 * j] = w; } };
        int m = gw;
        if (m < S) { ld(m, va);
            for (;;) { const int mb = m + NGW; const bool hb = mb < S; if (hb) ld(mb, vb);
                fin(m, va); if (!hb) break;
                m = mb + NGW; const bool ha = m < S; if (ha) ld(m, va);
                fin(mb, vb); if (!ha) break; } } }
}

__device__ __forceinline__ void phase_prepB_gu(const Ctx& C, int hf, int rank, int nranks) {
    LAS unsigned char* scr = C.lds + C.wave * 16384;
    constexpr int NBH = DFF / 128, I_H = (DM / 64) * NBH;
    bf16* WGU = (bf16*)(C.ws + WS_WGU);
    const float* const* in = C.in;
    auto dec = [=](int it) -> TrD { int r = it; const int up = r >= I_H; if (up) r -= I_H; const int kb = r / NBH, n0 = (hf * NBH + r % NBH) * 64;
        const size_t drow = (size_t)(n0 >> 7) * 256 + (n0 & 127) + (up ? 128 : 0);
        return TrD{up ? in[I_WU] : in[I_WG], in[I_N2W], WGU, drow, DFF, kb * 64, n0, DM, 0}; };
    tr_stream(rank * NWAVES + C.wave, 2 * I_H, nranks * NWAVES, dec, scr, C.lane);
}
__device__ __forceinline__ void phase_prepB_d(const Ctx& C, int rank, int nranks) {
    LAS unsigned char* scr = C.lds + C.wave * 16384;
    constexpr int I_D = (DFF / 64) * (DM / 64);
    bf16* WD = (bf16*)(C.ws + WS_WD);
    const float* wd = C.in[I_WD];
    auto dec = [=](int it) -> TrD { const int nb = DM / 64, kb = it / nb, n0 = (it % nb) * 64; return TrD{wd, nullptr, WD, (size_t)n0, DM, kb * 64, n0, DFF, 0}; };
    tr_stream(rank * NWAVES + C.wave, I_D, nranks * NWAVES, dec, scr, C.lane);
}

__device__ __forceinline__ float att_qkb(const float* qw, const float* kw, int lane) {
    float a = fmaxf(fabsf(qw[lane]), fabsf(qw[lane + 64])), b = fmaxf(fabsf(kw[lane]), fabsf(kw[lane + 64]));
#pragma unroll
    for (int o_ = 1; o_ < 64; o_ <<= 1) { a = fmaxf(a, __shfl_xor(a, o_)); b = fmaxf(b, __shfl_xor(b, o_)); }
    return 128.f * a * b * QSCALE_;
}
__device__ __forceinline__ bool att_live(int h, int m, float qkb) {
    const float sl2 = exp2f(-0.5f * (float)(h + 1)) * 1.4426950408889634f;
    return sl2 * (float)(256 * (m - 1) + 1) < qkb * 1.02f + 152.f;
}

__device__ __forceinline__ void phase_select(const Ctx& C) {
    typedef short bf16x8_ __attribute__((ext_vector_type(8))); typedef float f32x16_ __attribute__((ext_vector_type(16)));
    const bf16* P = (const bf16*)(C.ws + WS_P); const float* KMEAN = (const float*)(C.ws + WS_KMEAN);
    int* SELJ = (int*)(C.ws + WS_SELJ); int* CNT = (int*)(C.ws + WS_CNT); unsigned short* LIST = (unsigned short*)(C.ws + WS_LIST);
    LAS float* gt = (LAS float*)(C.lds + 16384);
    LAS int* wc = (LAS int*)(C.lds + 16384 + 33792);
    const float qkb = C.qkb;
    const int r32 = C.lane & 31, hi = C.lane >> 5;
#define SEL_HB(it, H_, B_) const int H_ = (it) & 15; const int B_ = ((it) >> 4) < 16 ? ((it) >> 4) : 47 - ((it) >> 4)
    f32x4 cvv[16]; float cvs[16]; int cv_it = C.vcu * NWAVES + C.wave; const int cv_stride = C.G * NWAVES; LAS unsigned char* cvscr = C.lds + 65536 + C.wave * 8192;
    bf16x8_ qf[8];
    if (C.vcu < NH * NBLK) { SEL_HB(C.vcu, h_, b_); const bf16* qrow = P + (size_t)(b_ * BLK + C.wave * 32 + r32) * INC + CQ + h_ * HD + hi * 8;
#pragma unroll
        for (int ks = 0; ks < 8; ++ks) qf[ks] = *(const bf16x8_*)(qrow + ks * 16); }
    for (int item = C.vcu; item < NH * NBLK; item += C.G) {
        SEL_HB(item, h, b);
        const int i = C.wave * 32 + r32, t = b * BLK + i;
        {
            f32x16_ acc = {};
            const float* krow = KMEAN + (size_t)(h * NBLK + r32) * HD + hi * 8;
#pragma unroll
            for (int ks = 0; ks < 8; ++ks) {
                const f32x4 k0 = *(const f32x4*)(krow + ks * 16), k1 = *(const f32x4*)(krow + ks * 16 + 4);
                const float kv[8] = {k0[0], k0[1], k0[2], k0[3], k1[0], k1[1], k1[2], k1[3]};
                unsigned hw[4], lw[4];
#pragma unroll
                for (int e = 0; e < 4; ++e) { const unsigned h0 = f2bf(kv[2 * e]), h1 = f2bf(kv[2 * e + 1]); hw[e] = h0 | (h1 << 16);
                    lw[e] = pk2(kv[2 * e] - bf2f(h0), kv[2 * e + 1] - bf2f(h1)); }
                const v4u hv = {hw[0], hw[1], hw[2], hw[3]}, lv = {lw[0], lw[1], lw[2], lw[3]};
                acc = __builtin_amdgcn_mfma_f32_32x32x16_bf16(qf[ks], __builtin_bit_cast(bf16x8_, hv), acc, 0, 0, 0);
                acc = __builtin_amdgcn_mfma_f32_32x32x16_bf16(qf[ks], __builtin_bit_cast(bf16x8_, lv), acc, 0, 0, 0); }
#pragma unroll
            for (int r = 0; r < 16; ++r) gt[(C.wave * 32 + (r & 3) + 8 * (r >> 2) + 4 * hi) * 33 + r32] = acc[r];
        }
        if (item + C.G < NH * NBLK) { SEL_HB(item + C.G, h_, b_); const bf16* qrow = P + (size_t)(b_ * BLK + C.wave * 32 + r32) * INC + CQ + h_ * HD + hi * 8;
#pragma unroll
            for (int ks = 0; ks < 8; ++ks) qf[ks] = *(const bf16x8_*)(qrow + ks * 16); }
        const bool cv_on = cv_it < SEL_NCV; TrD cvd; if (cv_on) { cvd = sel_cv_desc(C, cv_it); tr_load(cvd, cvv, cvs, C.lane); }
        __syncthreads();
        const int bh = (b + 1) >> 1, jlo = hi ? bh : 0, jhi = hi ? b : bh;
        int j0 = 255, j1 = 255, j2 = 255;
        { float v0 = -INFINITY, v1 = -INFINITY, v2 = -INFINITY;
          for (int j = jlo; j < jhi; ++j) { const float g = gt[i * 33 + j];
              if (g > v0) { v2 = v1; j2 = j1; v1 = v0; j1 = j0; v0 = g; j0 = j; }
              else if (g > v1) { v2 = v1; j2 = j1; v1 = g; j1 = j; }
              else if (g > v2) { v2 = g; j2 = j; } }
#define SWP(x, A_, B_) { const auto rr_ = __builtin_amdgcn_permlane32_swap(__float_as_uint(x), __float_as_uint(x), false, false); A_ = __uint_as_float(rr_[0]); B_ = __uint_as_float(rr_[1]); }
#define SWPI(x, A_, B_) { const auto rr_ = __builtin_amdgcn_permlane32_swap((unsigned)(x), (unsigned)(x), false, false); A_ = (int)rr_[0]; B_ = (int)rr_[1]; }
          float a0, a1, a2, b0, b1, b2; int ja0, ja1, ja2, jb0, jb1, jb2;
          SWP(v0, a0, b0); SWP(v1, a1, b1); SWP(v2, a2, b2); SWPI(j0, ja0, jb0); SWPI(j1, ja1, jb1); SWPI(j2, ja2, jb2);
#undef SWP
#undef SWPI
          bool ta = a0 >= b0; j0 = ta ? ja0 : jb0;
          { const float na0 = ta ? a1 : a0, na1 = ta ? a2 : a1; const int nja0 = ta ? ja1 : ja0, nja1 = ta ? ja2 : ja1;
            const float nb0 = ta ? b0 : b1, nb1 = ta ? b1 : b2; const int njb0 = ta ? jb0 : jb1, njb1 = ta ? jb1 : jb2;
            const bool tb = na0 >= nb0; j1 = tb ? nja0 : njb0;
            const float ma0 = tb ? na1 : na0, mb0 = tb ? nb0 : nb1; const int mja0 = tb ? nja1 : nja0, mjb0 = tb ? njb0 : njb1;
            j2 = (ma0 >= mb0) ? mja0 : mjb0; } }
        if (hi == 0) SELJ[t * NH + h] = j0 | (j1 << 8) | (j2 << 16);
        for (int jj = 0; jj < bh; ++jj) { const int j = jj + jlo; const bool hit = j < b && ((j0 == j) | (j1 == j) | (j2 == j)) && att_live(h, b - j, qkb);
            const unsigned long long bal = __ballot(hit); if (C.lane == 0) { wc[jj * 16 + C.wave * 2] = __popc((unsigned)bal); wc[jj * 16 + C.wave * 2 + 1] = __popc((unsigned)(bal >> 32)); } }
        __syncthreads();
        for (int jj = 0; jj < bh; ++jj) { const int j = jj + jlo; const bool hit = j < b && ((j0 == j) | (j1 == j) | (j2 == j)) && att_live(h, b - j, qkb);
            const unsigned long long bal = __ballot(hit); const unsigned mine = hi ? (unsigned)(bal >> 32) : (unsigned)bal;
            int off = 0;
#pragma unroll
            for (int wv = 0; wv < 8; ++wv) off += (wv < C.wave) ? wc[jj * 16 + wv * 2 + hi] : 0;
            off += __popc(mine & ((1u << r32) - 1u));
            const int slot = (j0 == j) ? 0 : (j1 == j) ? 1 : 2;
            if (hit) LIST[((size_t)(h * NBLK + j) * NBLK + b) * BLK + off] = (unsigned short)(i | (slot << 8)); }
        if (C.tid < b) { const int j = C.tid, hf = j >= bh, jj = j - (hf ? bh : 0); int nsum = 0;
#pragma unroll
            for (int wv = 0; wv < 8; ++wv) nsum += wc[jj * 16 + wv * 2 + hf];
            CNT[(h * NBLK + j) * NBLK + b] = nsum; }
        if (cv_on) { tr_finish(cvd, cvv, cvs, cvscr, C.lane); cv_it += cv_stride; }
        __syncthreads();
    }
    for (; cv_it < SEL_NCV; cv_it += cv_stride) { const TrD d = sel_cv_desc(C, cv_it); tr_load(d, cvv, cvs, C.lane); tr_finish(d, cvv, cvs, cvscr, C.lane); }
#undef SEL_HB
}

#define LSWZ(row, colB) ((row) * 256 + ((colB) ^ (((row) & 7) << 4)))
typedef float f32x2_ __attribute__((ext_vector_type(2)));
struct TrueT { static constexpr bool value = true; }; struct FalseT { static constexpr bool value = false; };
__device__ __forceinline__ unsigned cvt_pk_bf16_(float lo, float hi) { unsigned r; asm volatile("v_cvt_pk_bf16_f32 %0, %1, %2" : "=v"(r) : "v"(lo), "v"(hi)); return r; }
__device__ __forceinline__ f32x2_ bfpair(unsigned w) { f32x2_ r; r.x = bflo(w); r.y = bfhi(w); return r; }
__device__ __forceinline__ f32x2_ exp2_2(f32x2_ v) { f32x2_ r; r.x = __builtin_amdgcn_exp2f(v.x); r.y = __builtin_amdgcn_exp2f(v.y); return r; }
__device__ __forceinline__ f32x2_ rcp_2(f32x2_ v) { f32x2_ r; r.x = __builtin_amdgcn_rcpf(v.x); r.y = __builtin_amdgcn_rcpf(v.y); return r; }
template <int MODE> __device__ __forceinline__ void phase_lru(const Ctx& C) {
    typedef short bf16x8_ __attribute__((ext_vector_type(8))); typedef float f32x16_ __attribute__((ext_vector_type(16)));
    const bf16* P = (const bf16*)(C.ws + WS_P); bf16* AL = (bf16*)(C.ws + WS_AL); float* LAGG = (float*)(C.ws + WS_LAGG); const bf16* WRG = (const bf16*)(C.ws + WS_WRG);
    bf16* LX2 = (bf16*)(C.ws + WS_LX2); bf16* LBX = (bf16*)(C.ws + WS_LBX);
    LAS unsigned char* Ub = C.lds;
    LAS float* A = (LAS float*)(C.lds + 16384);
    LAS float* BX = (LAS float*)(C.lds + 49152);
    LAS unsigned char* G = C.lds + 81920;
    LAS unsigned char* OUTI = C.lds + 98304;
    LAS f32x4* SEG = (LAS f32x4*)(C.lds + 114688);
    LAS unsigned char* XR = C.lds + 122880;
    LAS unsigned char* YR = C.lds + 122880 + 17152;
    const int lane = C.lane, r32 = lane & 31, hi = lane >> 5, th = C.wave >> 2, db = C.wave & 3;
    const int cp = lane, sg = C.wave;
    constexpr float L2E = 1.4426950408889634f;
    for (int item = C.vcu; item < 256; item += C.G) {
        const int n = item & 15, c = item >> 4, ch0 = n * 128, t0 = c * 512;
        f32x2_ cw0, cw1, cw2, cw3, cb;
        { const float* w = C.in[I_CONVW] + ch0 + 2 * cp; cw0 = *(const f32x2_*)w; cw1 = *(const f32x2_*)(w + DM); cw2 = *(const f32x2_*)(w + 2 * DM); cw3 = *(const f32x2_*)(w + 3 * DM); cb = *(const f32x2_*)(C.in[I_CONVB] + ch0 + 2 * cp); }
        const int dcol = db * 32 + r32;
        const float ba = C.in[I_BRGA][ch0 + dcol], bxb = C.in[I_BRGX][ch0 + dcol];
        const float sp8 = 8.0f * log1pf(__expf(-C.in[I_LAM][ch0 + dcol]));
        bf16x8_ wa[8], wx[8];
#pragma unroll
        for (int ks = 0; ks < 8; ++ks) { wa[ks] = *(const bf16x8_*)(WRG + (size_t)((n * 2 + 0) * 128 + dcol) * 128 + ks * 16 + hi * 8);
                                         wx[ks] = *(const bf16x8_*)(WRG + (size_t)((n * 2 + 1) * 128 + dcol) * 128 + ks * 16 + hi * 8); }
        f32x2_ hst = {0.f, 0.f}, aprod = {1.f, 1.f};
        if (MODE == 1) { for (int cc = 0; cc < c; ++cc) { const f32x4 ag = *(const f32x4*)(LAGG + (size_t)(cc * 2048 + ch0 + 2 * cp) * 2); hst.x = ag[0] * hst.x + ag[1]; hst.y = ag[2] * hst.y + ag[3]; } }
#define LBAR() do { asm volatile("s_waitcnt lgkmcnt(0)" ::: "memory"); __builtin_amdgcn_s_barrier(); asm volatile("" ::: "memory"); } while (0)
#define LRU_DMA(tsub) do { \
            for (int r_ = C.wave; r_ < 67; r_ += 8) { int tt_ = (tsub) - 3 + r_; if (tt_ < 0) tt_ = 0; \
                __builtin_amdgcn_global_load_lds((const unsigned*)(P + (size_t)tt_ * INC + CXR + ch0 + 2 * lane), (LAS unsigned*)(XR + r_ * 256), 4, 0, 0); } \
            if (MODE == 1) { for (int r_ = C.wave; r_ < 64; r_ += 8) \
                __builtin_amdgcn_global_load_lds((const unsigned*)(P + (size_t)((tsub) + r_) * INC + CYR + ch0 + 2 * lane), (LAS unsigned*)(YR + r_ * 256), 4, 0, 0); } } while (0)
        LRU_DMA(t0);
        asm volatile("s_waitcnt vmcnt(0)" ::: "memory"); LBAR();
        for (int sc = 0; sc < 8; ++sc) {
            const int ts = t0 + sc * 64;
            { f32x2_ x0 = bfpair(*(const LAS unsigned*)(XR + (sg * 8 + 0) * 256 + 4 * cp)), x1 = bfpair(*(const LAS unsigned*)(XR + (sg * 8 + 1) * 256 + 4 * cp)), x2_ = bfpair(*(const LAS unsigned*)(XR + (sg * 8 + 2) * 256 + 4 * cp));
              if (ts + sg * 8 == 0) { x0 = (f32x2_){0.f, 0.f}; x1 = x0; x2_ = x0; }
#pragma unroll
              for (int k = 0; k < 8; ++k) { const int tr = sg * 8 + k; const f32x2_ x3 = bfpair(*(const LAS unsigned*)(XR + (tr + 3) * 256 + 4 * cp));
                  const f32x2_ uu = cb + cw0 * x0 + cw1 * x1 + cw2 * x2_ + cw3 * x3; x0 = x1; x1 = x2_; x2_ = x3;
                  *(LAS unsigned*)(Ub + LSWZ(tr, 4 * cp)) = cvt_pk_bf16_(uu.x, uu.y);
                  if (MODE == 1) { const f32x2_ y = bfpair(*(const LAS unsigned*)(YR + tr * 256 + 4 * cp));
                      const f32x2_ e2 = exp2_2((y + (y * y) * y * 0.044715f) * (-1.5957691216057308f * L2E));
                      const f32x2_ gy = y * rcp_2(e2 + 1.f); *(LAS unsigned*)(G + tr * 256 + 4 * cp) = cvt_pk_bf16_(gy.x, gy.y); } } }
            LBAR();
            if (sc < 7) LRU_DMA(ts + 64);
            if (MODE == 1 && sc > 0) {
#pragma unroll
                for (int i = 0; i < 2; ++i) { const int pc = C.tid + i * NTHR, tr = pc >> 4, cq = pc & 15;
                    *(v4u*)(AL + (size_t)(ts - 64 + tr) * 4096 + 2048 + ch0 + cq * 8) = *(const LAS v4u*)(OUTI + tr * 256 + cq * 16); } }
            { f32x16_ accA = {}, accX = {};
#pragma unroll
              for (int ks = 0; ks < 8; ++ks) { const bf16x8_ af = *(const LAS bf16x8_*)(Ub + LSWZ(th * 32 + r32, (ks * 16 + hi * 8) * 2));
                  accA = __builtin_amdgcn_mfma_f32_32x32x16_bf16(af, wa[ks], accA, 0, 0, 0); accX = __builtin_amdgcn_mfma_f32_32x32x16_bf16(af, wx[ks], accX, 0, 0, 0); }
              f32x2_ x2v[8]; bool slow = false;
#pragma unroll
              for (int rp = 0; rp < 8; ++rp) { const f32x2_ za = ((f32x2_){accA[2 * rp], accA[2 * rp + 1]} + ba) * (-L2E);
                  x2v[rp] = rcp_2(exp2_2(za) + 1.f) * (-2.0f * sp8); slow |= (x2v[rp].x <= -0.25f) | (x2v[rp].y <= -0.25f); }
              const bool anyslow = __any(slow);
#pragma unroll
              for (int rp = 0; rp < 8; ++rp) { const int r = 2 * rp; const int tr = th * 32 + (r & 3) + 8 * (r >> 2) + 4 * hi;
                  f32x2_ u; u.x = bf2f(*(const LAS unsigned short*)(Ub + LSWZ(tr, 2 * dcol))); u.y = bf2f(*(const LAS unsigned short*)(Ub + LSWZ(tr + 1, 2 * dcol)));
                  const f32x2_ zi = ((f32x2_){accX[r], accX[r + 1]} + bxb) * (-L2E); const f32x2_ ig = rcp_2(exp2_2(zi) + 1.f);
                  const f32x2_ x2 = x2v[rp]; const f32x2_ a = exp2_2(x2 * (0.5f * L2E));
                  f32x2_ om = -x2 * (x2 * (x2 * (x2 * (x2 * 0.008333334f + 0.041666668f) + 0.16666667f) + 0.5f) + 1.f);
                  if (anyslow) { const f32x2_ ex = exp2_2(x2 * L2E); om.x = (x2.x > -0.25f) ? om.x : 1.f - ex.x; om.y = (x2.y > -0.25f) ? om.y : 1.f - ex.y; }
                  f32x2_ sq; sq.x = __builtin_amdgcn_sqrtf(om.x); sq.y = __builtin_amdgcn_sqrtf(om.y);
                  const f32x2_ bx = sq * ig * u;
                  A[tr * 128 + dcol] = a.x; A[(tr + 1) * 128 + dcol] = a.y; BX[tr * 128 + dcol] = bx.x; BX[(tr + 1) * 128 + dcol] = bx.y;
                  if (MODE == 0) { *(LAS unsigned short*)(G + tr * 256 + 2 * dcol) = (unsigned short)(cvt_pk_bf16_(x2.x, 0.f)); *(LAS unsigned short*)(G + (tr + 1) * 256 + 2 * dcol) = (unsigned short)(cvt_pk_bf16_(x2.y, 0.f));
                                   *(LAS unsigned short*)(OUTI + tr * 256 + 2 * dcol) = (unsigned short)(cvt_pk_bf16_(bx.x, 0.f)); *(LAS unsigned short*)(OUTI + (tr + 1) * 256 + 2 * dcol) = (unsigned short)(cvt_pk_bf16_(bx.y, 0.f)); } } }
            LBAR();
            if (MODE == 0) {
#pragma unroll
                for (int i = 0; i < 2; ++i) { const int pc = C.tid + i * NTHR, tr = pc >> 4, cq = pc & 15; const size_t go = (size_t)(ts + tr) * 4096 + ch0 + cq * 8;
                    *(v4u*)(LX2 + go) = *(const LAS v4u*)(G + tr * 256 + cq * 16); *(v4u*)(LBX + go) = *(const LAS v4u*)(OUTI + tr * 256 + cq * 16); } }
            { f32x2_ ap = {1.f, 1.f}, hl = {0.f, 0.f};
#pragma unroll
              for (int k = 0; k < 8; ++k) { const f32x2_ a = *(const LAS f32x2_*)(A + (sg * 8 + k) * 128 + 2 * cp); hl = a * hl + *(const LAS f32x2_*)(BX + (sg * 8 + k) * 128 + 2 * cp); ap = ap * a; }
              SEG[sg * 64 + cp] = (f32x4){ap.x, ap.y, hl.x, hl.y}; }
            LBAR();
            { f32x2_ hin = hst, hrun = hst, arun = {1.f, 1.f};
#pragma unroll
              for (int s = 0; s < 8; ++s) { const f32x4 sv = SEG[s * 64 + cp]; const f32x2_ as_ = {sv[0], sv[1]}, hs_ = {sv[2], sv[3]}; if (s == sg) hin = hrun; hrun = as_ * hrun + hs_; arun = arun * as_; }
              hst = hrun; aprod = aprod * arun;
              if (MODE == 1) {
#pragma unroll
                  for (int k = 0; k < 8; ++k) { const int tr = sg * 8 + k; hin = *(const LAS f32x2_*)(A + tr * 128 + 2 * cp) * hin + *(const LAS f32x2_*)(BX + tr * 128 + 2 * cp);
                      const f32x2_ yv = hin * bfpair(*(const LAS unsigned*)(G + tr * 256 + 4 * cp));
                      *(LAS unsigned*)(OUTI + tr * 256 + 4 * cp) = cvt_pk_bf16_(yv.x, yv.y); } } }
            asm volatile("s_waitcnt vmcnt(0)" ::: "memory"); LBAR();
        }
        if (MODE == 1) {
#pragma unroll
            for (int i = 0; i < 2; ++i) { const int pc = C.tid + i * NTHR, tr = pc >> 4, cq = pc & 15;
                *(v4u*)(AL + (size_t)(t0 + 448 + tr) * 4096 + 2048 + ch0 + cq * 8) = *(const LAS v4u*)(OUTI + tr * 256 + cq * 16); }
            asm volatile("s_waitcnt lgkmcnt(0)" ::: "memory"); __builtin_amdgcn_s_barrier();
        }
        if (MODE == 0 && sg == 0) *(f32x4*)(LAGG + (size_t)(c * 2048 + ch0 + 2 * cp) * 2) = (f32x4){aprod.x, hst.x, aprod.y, hst.y};
    }
#undef LRU_DMA
#undef LBAR
}

typedef short lru_bf16x8 __attribute__((ext_vector_type(8)));
struct LruPar { f32x2_ cw0, cw1, cw2, cw3, cb; float ba, bxb, lam; lru_bf16x8 wa[8], wx[8]; };
__device__ __forceinline__ void lru_par_load(const Ctx& C, int item, LruPar& L) {
    typedef short bf16x8_ __attribute__((ext_vector_type(8)));
    const bf16* WRG = (const bf16*)(C.ws + WS_WRG);
    const int lane = C.lane, r32 = lane & 31, hi = lane >> 5, db = C.wave & 3, cp = lane;
    const int n = item & 15, ch0 = n * 128, dcol = db * 32 + r32;
    const float* w = C.in[I_CONVW] + ch0 + 2 * cp; L.cw0 = *(const f32x2_*)w; L.cw1 = *(const f32x2_*)(w + DM); L.cw2 = *(const f32x2_*)(w + 2 * DM); L.cw3 = *(const f32x2_*)(w + 3 * DM); L.cb = *(const f32x2_*)(C.in[I_CONVB] + ch0 + 2 * cp);
    L.ba = C.in[I_BRGA][ch0 + dcol]; L.bxb = C.in[I_BRGX][ch0 + dcol]; L.lam = C.in[I_LAM][ch0 + dcol];
#pragma unroll
    for (int ks = 0; ks < 8; ++ks) { L.wa[ks] = *(const bf16x8_*)(WRG + (size_t)((n * 2 + 0) * 128 + dcol) * 128 + ks * 16 + hi * 8);
                                     L.wx[ks] = *(const bf16x8_*)(WRG + (size_t)((n * 2 + 1) * 128 + dcol) * 128 + ks * 16 + hi * 8); }
}
__device__ __forceinline__ void phase_lru_a(const Ctx& C, LruPar& L) {
    typedef short bf16x8_ __attribute__((ext_vector_type(8))); typedef float f32x16_ __attribute__((ext_vector_type(16)));
    const bf16* P = (const bf16*)(C.ws + WS_P); float* LAGG = (float*)(C.ws + WS_LAGG); const bf16* WRG = (const bf16*)(C.ws + WS_WRG);
    bf16* LX2 = (bf16*)(C.ws + WS_LX2); bf16* LBX = (bf16*)(C.ws + WS_LBX);
    constexpr int O_UB = 0, O_G = 32768, O_OI = 65536, O_XR = 98304, XRB = 17152, O_AGG = O_XR + 2 * XRB;
    static_assert(O_AGG + 16384 <= 163584, "LRU-A LDS map");
    const int lane = C.lane, r32 = lane & 31, hi = lane >> 5, th = C.wave >> 2, db = C.wave & 3;
    const int cp = lane, sg = C.wave;
    constexpr float L2E = 1.4426950408889634f;
    LAS f32x2_* AGG = (LAS f32x2_*)(C.lds + O_AGG);
    for (int item = C.vcu; item < 256; item += C.G) {
        const int n = item & 15, c = item >> 4, ch0 = n * 128, t0 = c * 512;
        const f32x2_ cw0 = L.cw0, cw1 = L.cw1, cw2 = L.cw2, cw3 = L.cw3, cb = L.cb;
        const int dcol = db * 32 + r32;
        const float ba = L.ba, bxb = L.bxb;
        const float sp8 = 8.0f * log1pf(__expf(-L.lam));
        bf16x8_ wa[8], wx[8];
#pragma unroll
        for (int ks = 0; ks < 8; ++ks) { wa[ks] = L.wa[ks]; wx[ks] = L.wx[ks]; }
#define LBAR() do { asm volatile("s_waitcnt lgkmcnt(0)" ::: "memory"); __builtin_amdgcn_s_barrier(); asm volatile("" ::: "memory"); } while (0)
#define LRU_DMA(buf, tsub) do { \
            for (int r_ = C.wave; r_ < 67; r_ += 8) { int tt_ = (tsub) - 3 + r_; if (tt_ < 0) tt_ = 0; \
                __builtin_amdgcn_global_load_lds((const unsigned*)(P + (size_t)tt_ * INC + CXR + ch0 + 2 * lane), (LAS unsigned*)(C.lds + O_XR + (buf) * XRB + r_ * 256), 4, 0, 0); } } while (0)
#define LRU_CONV(sub) do { const LAS unsigned char* XR_ = C.lds + O_XR + ((sub) & 1) * XRB; LAS unsigned char* Ub_ = C.lds + O_UB + ((sub) & 1) * 16384; \
            unsigned xw_[11]; _Pragma("unroll") for (int k = 0; k < 11; ++k) xw_[k] = *(const LAS unsigned*)(XR_ + (sg * 8 + k) * 256 + 4 * cp);     \
            f32x2_ x0 = bfpair(xw_[0]), x1 = bfpair(xw_[1]), x2_ = bfpair(xw_[2]); \
            if (t0 + (sub) * 64 + sg * 8 == 0) { x0 = (f32x2_){0.f, 0.f}; x1 = x0; x2_ = x0; } \
            unsigned uw_[8]; \
            _Pragma("unroll") for (int k = 0; k < 8; ++k) { const f32x2_ x3 = bfpair(xw_[k + 3]); \
                const f32x2_ uu = cb + cw0 * x0 + cw1 * x1 + cw2 * x2_ + cw3 * x3; x0 = x1; x1 = x2_; x2_ = x3; uw_[k] = cvt_pk_bf16_(uu.x, uu.y); } \
            _Pragma("unroll") for (int k = 0; k < 8; ++k) *(LAS unsigned*)(Ub_ + LSWZ(sg * 8 + k, 4 * cp)) = uw_[k]; } while (0)
        __syncthreads();
        LRU_DMA(0, t0); LRU_DMA(1, t0 + 64);
        asm volatile("s_waitcnt vmcnt(0)" ::: "memory"); LBAR();
        LRU_CONV(0);
        LBAR();
        for (int sc = 0; sc < 8; ++sc) {
            const int ts = t0 + sc * 64;
            if (sc + 2 < 8) LRU_DMA(sc & 1, ts + 128);
            if (sc > 0) { const LAS unsigned char* G_ = C.lds + O_G + ((sc - 1) & 1) * 16384; const LAS unsigned char* OI_ = C.lds + O_OI + ((sc - 1) & 1) * 16384;
#pragma unroll
                for (int i = 0; i < 2; ++i) { const int pc = C.tid + i * NTHR, tr = pc >> 4, cq = pc & 15; const size_t go = (size_t)(ts - 64 + tr) * 4096 + ch0 + cq * 8;
                    *(v4u*)(LX2 + go) = *(const LAS v4u*)(G_ + tr * 256 + cq * 16); *(v4u*)(LBX + go) = *(const LAS v4u*)(OI_ + tr * 256 + cq * 16); } }
            if (sc + 1 < 8) LRU_CONV(sc + 1);
            {
                const LAS unsigned char* Ub = C.lds + O_UB + (sc & 1) * 16384; LAS unsigned char* G = C.lds + O_G + (sc & 1) * 16384; LAS unsigned char* OUTI = C.lds + O_OI + (sc & 1) * 16384;
                f32x16_ accA = {}, accX = {};
                unsigned short uraw[16];
#pragma unroll
                for (int r = 0; r < 16; ++r) uraw[r] = *(const LAS unsigned short*)(Ub + LSWZ(th * 32 + (r & 3) + 8 * (r >> 2) + 4 * hi, 2 * dcol));
#pragma unroll
                for (int ks = 0; ks < 8; ++ks) { const bf16x8_ af = *(const LAS bf16x8_*)(Ub + LSWZ(th * 32 + r32, (ks * 16 + hi * 8) * 2));
                    accA = __builtin_amdgcn_mfma_f32_32x32x16_bf16(af, wa[ks], accA, 0, 0, 0); accX = __builtin_amdgcn_mfma_f32_32x32x16_bf16(af, wx[ks], accX, 0, 0, 0); }
                f32x2_ x2v[8]; bool slow = false;
#pragma unroll
                for (int rp = 0; rp < 8; ++rp) { const f32x2_ za = ((f32x2_){accA[2 * rp], accA[2 * rp + 1]} + ba) * (-L2E);
                    x2v[rp] = rcp_2(exp2_2(za) + 1.f) * (-2.0f * sp8); slow |= (x2v[rp].x <= -0.25f) | (x2v[rp].y <= -0.25f); }
                const bool anyslow = __any(slow);
                float gA[4], gH[4];
                auto gate_rows = [&](auto slowc) {
#pragma unroll
                for (int rp = 0; rp < 8; ++rp) { const int r = 2 * rp; const int tr = th * 32 + (r & 3) + 8 * (r >> 2) + 4 * hi;
                    f32x2_ u; u.x = bf2f(uraw[r]); u.y = bf2f(uraw[r + 1]);
                    const f32x2_ zi = ((f32x2_){accX[r], accX[r + 1]} + bxb) * (-L2E); const f32x2_ ig = rcp_2(exp2_2(zi) + 1.f);
                    const f32x2_ x2 = x2v[rp]; const f32x2_ a = exp2_2(x2 * (0.5f * L2E));
                    f32x2_ om = -x2 * (x2 * (x2 * (x2 * (x2 * 0.008333334f + 0.041666668f) + 0.16666667f) + 0.5f) + 1.f);
                    if constexpr (decltype(slowc)::value) { const f32x2_ ex = exp2_2(x2 * L2E); om.x = (x2.x > -0.25f) ? om.x : 1.f - ex.x; om.y = (x2.y > -0.25f) ? om.y : 1.f - ex.y; }
                    f32x2_ sq; sq.x = __builtin_amdgcn_sqrtf(om.x); sq.y = __builtin_amdgcn_sqrtf(om.y);
                    const f32x2_ bx = sq * ig * u;
                    if ((rp & 1) == 0) { gA[rp >> 1] = a.x * a.y; gH[rp >> 1] = bx.x * a.y + bx.y; }
                    else { const float h1 = gH[rp >> 1] * a.x + bx.x; gH[rp >> 1] = h1 * a.y + bx.y; gA[rp >> 1] *= a.x * a.y; }
                    *(LAS unsigned short*)(G + tr * 256 + 2 * dcol) = (unsigned short)(cvt_pk_bf16_(x2.x, 0.f)); *(LAS unsigned short*)(G + (tr + 1) * 256 + 2 * dcol) = (unsigned short)(cvt_pk_bf16_(x2.y, 0.f));
                    *(LAS unsigned short*)(OUTI + tr * 256 + 2 * dcol) = (unsigned short)(cvt_pk_bf16_(bx.x, 0.f)); *(LAS unsigned short*)(OUTI + (tr + 1) * 256 + 2 * dcol) = (unsigned short)(cvt_pk_bf16_(bx.y, 0.f)); } };
                if (anyslow) gate_rows(TrueT{}); else gate_rows(FalseT{});
                float Aw = 1.f, Hw = 0.f;
#pragma unroll
                for (int g = 0; g < 4; ++g) { const auto ra = __builtin_amdgcn_permlane32_swap(__float_as_uint(gA[g]), __float_as_uint(gA[g]), false, false);
                    const auto rh = __builtin_amdgcn_permlane32_swap(__float_as_uint(gH[g]), __float_as_uint(gH[g]), false, false);
                    const float a0 = __uint_as_float(ra[0]), a1 = __uint_as_float(ra[1]), h0 = __uint_as_float(rh[0]), h1 = __uint_as_float(rh[1]);
                    Hw = a0 * Hw + h0; Hw = a1 * Hw + h1; Aw *= a0 * a1; }
                if (hi == 0) AGG[(sc * 2 + th) * 128 + dcol] = (f32x2_){Aw, Hw};
            }
            if (sc == 0) asm volatile("s_waitcnt vmcnt(0)" ::: "memory"); else asm volatile("s_waitcnt vmcnt(4)" ::: "memory");
            LBAR();
        }
        {
            const LAS unsigned char* G_ = C.lds + O_G + 16384; const LAS unsigned char* OI_ = C.lds + O_OI + 16384;
#pragma unroll
            for (int i = 0; i < 2; ++i) { const int pc = C.tid + i * NTHR, tr = pc >> 4, cq = pc & 15; const size_t go = (size_t)(t0 + 448 + tr) * 4096 + ch0 + cq * 8;
                *(v4u*)(LX2 + go) = *(const LAS v4u*)(G_ + tr * 256 + cq * 16); *(v4u*)(LBX + go) = *(const LAS v4u*)(OI_ + tr * 256 + cq * 16); }
            if (C.tid < 128) { float Ar = 1.f, Hr = 0.f;
#pragma unroll
                for (int k = 0; k < 16; ++k) { const f32x2_ ag = AGG[k * 128 + C.tid]; Hr = ag.x * Hr + ag.y; Ar *= ag.x; }
                *(f32x2_*)(LAGG + (size_t)(c * 2048 + ch0 + C.tid) * 2) = (f32x2_){Ar, Hr}; }
        }
        if (item + C.G < 256) lru_par_load(C, item + C.G, L);
    }
#undef LRU_CONV
#undef LRU_DMA
#undef LBAR
}

__device__ __forceinline__ void phase_lru_b(const Ctx& C) {
    const bf16* P = (const bf16*)(C.ws + WS_P); bf16* AL = (bf16*)(C.ws + WS_AL); const float* LAGG = (const float*)(C.ws + WS_LAGG);
    const bf16* LX2 = (const bf16*)(C.ws + WS_LX2); const bf16* LBX = (const bf16*)(C.ws + WS_LBX);
    LAS f32x4* SEG = (LAS f32x4*)(C.lds);
    const int cp = C.lane, sg = C.wave; constexpr float L2E = 1.4426950408889634f;
    for (int item = C.vcu; item < 256; item += C.G) {
        const int n = item & 15, c = item >> 4, ch0 = n * 128, t0 = c * 512;
        f32x2_ hst = {0.f, 0.f};
        for (int cc = 0; cc < c; ++cc) { const f32x4 ag = *(const f32x4*)(LAGG + (size_t)(cc * 2048 + ch0 + 2 * cp) * 2); hst.x = ag[0] * hst.x + ag[1]; hst.y = ag[2] * hst.y + ag[3]; }
        unsigned xw[8], bw[8], yw[8], xn[8], bn[8], yn[8];
#define LB_LOAD(X, B, Y, tsub) do { _Pragma("unroll") for (int k = 0; k < 8; ++k) { const size_t t_ = (size_t)((tsub) + sg * 8 + k); \
            X[k] = *(const unsigned*)(LX2 + t_ * 4096 + ch0 + 2 * cp); B[k] = *(const unsigned*)(LBX + t_ * 4096 + ch0 + 2 * cp); Y[k] = *(const unsigned*)(P + t_ * INC + CYR + ch0 + 2 * cp); } } while (0)
        LB_LOAD(xw, bw, yw, t0);
        __syncthreads();
        for (int sc = 0; sc < 8; ++sc) {
            const int ts = t0 + sc * 64; LAS f32x4* SG = SEG + (sc & 1) * 512;
            if (sc < 7) LB_LOAD(xn, bn, yn, ts + 64);
            f32x2_ av[8], bv[8]; f32x2_ ap = {1.f, 1.f}, hl = {0.f, 0.f};
#pragma unroll
            for (int k = 0; k < 8; ++k) { av[k] = exp2_2(bfpair(xw[k]) * (0.5f * L2E)); bv[k] = bfpair(bw[k]); hl = av[k] * hl + bv[k]; ap = ap * av[k]; }
            SG[sg * 64 + cp] = (f32x4){ap.x, ap.y, hl.x, hl.y};
            asm volatile("s_waitcnt lgkmcnt(0)" ::: "memory"); __builtin_amdgcn_s_barrier(); asm volatile("" ::: "memory");
            f32x2_ hin = hst, hrun = hst;
#pragma unroll
            for (int s = 0; s < 8; ++s) { const f32x4 sv = SG[s * 64 + cp]; const f32x2_ as_ = {sv[0], sv[1]}, hs_ = {sv[2], sv[3]}; if (s == sg) hin = hrun; hrun = as_ * hrun + hs_; }
            hst = hrun;
#pragma unroll
            for (int k = 0; k < 8; ++k) { hin = av[k] * hin + bv[k]; const f32x2_ y = bfpair(yw[k]);
                const f32x2_ e2 = exp2_2((y + (y * y) * y * 0.044715f) * (-1.5957691216057308f * L2E)); const f32x2_ yv = hin * y * rcp_2(e2 + 1.f);
                *(unsigned*)(AL + (size_t)(ts + sg * 8 + k) * 4096 + 2048 + ch0 + 2 * cp) = cvt_pk_bf16_(yv.x, yv.y); }
#pragma unroll
            for (int k = 0; k < 8; ++k) { xw[k] = xn[k]; bw[k] = bn[k]; yw[k] = yn[k]; }
        }
#undef LB_LOAD
    }
}

namespace pg8 {
typedef short bf16x8 __attribute__((ext_vector_type(8)));
typedef unsigned u32x4 __attribute__((ext_vector_type(4)));
constexpr int BM = 256, BK = 64, HALF = 128, HTB = HALF * BK * 2, STAGE_BYTES = 8 * HTB, NXCD = 8, WGM = 8;
__host__ __device__ __forceinline__ int lds_byte(int r, int c) { const int st = (r >> 4) * 2 + (c >> 5), rr = r & 15, cc = c & 31, ob = rr * 64 + cc * 2; return st * 1024 + (ob ^ (((ob >> 9) & 1) << 5)); }
__host__ __device__ __forceinline__ void stage_rc(int b, int& R, int& C) { const int st = b / 1024, sb = b % 1024, swz = sb ^ (((sb >> 9) & 1) << 5); R = (st >> 1) * 16 + swz / 64; C = (st & 1) * 32 + (swz % 64) / 2; }
__host__ __device__ __forceinline__ int perm32(int rho) { const int n = rho >> 4, i = rho & 15; return 8 * (i >> 2) + 4 * n + (i & 3); }
struct Unit { int pm, pn; };
struct Gemm { const bf16* A; const bf16* Bt; int lda, ldb, M, N, K; };
struct StaticOrder {
    int nM, nN, nwg, G, c;
    __device__ void init(int M, int N, int G_, int c_) { nM = M / BM; nN = N / BM; nwg = nM * nN; G = G_; c = c_; }
    __device__ bool next(int i, Unit& u) const {
        const long L = (long)i * G + c; if (L >= nwg) return false;
        int wgid = (int)L; { const int q = nwg / NXCD, r = nwg % NXCD, xcd = wgid % NXCD, off = wgid / NXCD; wgid = (xcd < r ? xcd * (q + 1) : r * (q + 1) + (xcd - r) * q) + off; }
        const int nig = WGM * nN, gid = wgid / nig, fm = gid * WGM, gsz = (nM - fm) < WGM ? (nM - fm) : WGM;
        u.pm = fm + ((wgid % nig) % gsz); u.pn = (wgid % nig) / gsz; return true;
    }
};
__device__ __forceinline__ unsigned cvt_pk_bf16(float lo, float hi) { unsigned r; asm volatile("v_cvt_pk_bf16_f32 %0, %1, %2" : "=v"(r) : "v"(lo), "v"(hi)); return r; }
typedef f32x4 Acc[2][2][4][2];

template <class Epi, bool ALIGN_EPI>
__device__ __forceinline__ void gemm_phase(LAS unsigned char* lds, const Gemm g, const StaticOrder& S, const Epi& E) {
    const int tid = threadIdx.x, wid = __builtin_amdgcn_readfirstlane(tid >> 6), lane = tid & 63, wr = wid >> 2, wc = wid & 3, fr = lane & 15, fq = lane >> 4;
    const int K = g.K, nt = K / BK;
    unsigned voffA[2], voffB[2];
#pragma unroll
    for (int i = 0; i < 2; ++i) { int R, C; stage_rc(tid * 16 + i * 8192, R, C); const int Rb = Epi::PERM ? ((R & ~31) + perm32(R & 31)) : R;
        voffA[i] = (unsigned)(R * g.lda + C) * 2u; voffB[i] = (unsigned)(Rb * g.ldb + C) * 2u; }
    const size_t kstep = (size_t)(BK * 2);
    const size_t hstepA = (size_t)HALF * g.lda * 2, hstepB = (size_t)HALF * g.ldb * 2;
    const size_t tstepA = 2 * hstepA, tstepB = 2 * hstepB;
    const unsigned ldsw = (unsigned)wid * 1024u;
    const int aoff = lds_byte(wr * 64 + fr, fq * 8), boff = lds_byte(wc * 32 + fr, fq * 8);
#define PG8_SA(b, h) (((b) * 2 + (h)) * HTB)
#define PG8_SB(b, h) ((4 + (b) * 2 + (h)) * HTB)
#define PG8_STAGE(bufoff, gbase, voff) do { _Pragma("unroll") for (int _i = 0; _i < 2; ++_i) \
        __builtin_amdgcn_global_load_lds((const unsigned*)((const char*)(gbase) + (voff)[_i]), (LAS unsigned*)(lds + (bufoff) + ldsw + _i * 8192), 16, 0, 0); } while (0)
#define PG8_LDA(dst, b, h) do { _Pragma("unroll") for (int m = 0; m < 4; ++m) _Pragma("unroll") for (int k = 0; k < 2; ++k) dst[m][k] = *(const LAS bf16x8*)(lds + PG8_SA(b, h) + aoff + m * 2048 + k * 1024); } while (0)
#define PG8_LDB(dst, b, h) do { _Pragma("unroll") for (int n = 0; n < 2; ++n) _Pragma("unroll") for (int k = 0; k < 2; ++k) dst[n][k] = *(const LAS bf16x8*)(lds + PG8_SB(b, h) + boff + n * 2048 + k * 1024); } while (0)
#define PG8_MMA(ai, bj, At, Bt) do { __builtin_amdgcn_s_setprio(1); _Pragma("unroll") for (int m = 0; m < 4; ++m) _Pragma("unroll") for (int n = 0; n < 2; ++n) _Pragma("unroll") for (int k = 0; k < 2; ++k) \
        acc[ai][bj][m][n] = __builtin_amdgcn_mfma_f32_16x16x32_bf16(Bt[n][k], At[m][k], acc[ai][bj][m][n], 0, 0, 0); __builtin_amdgcn_s_setprio(0); } while (0)
#define PG8_WAIT_V(n) asm volatile("s_waitcnt vmcnt(" #n ")" ::: "memory")
#define PG8_WAIT_L(n) asm volatile("s_waitcnt lgkmcnt(" #n ")" ::: "memory")
#define PG8_BAR __builtin_amdgcn_s_barrier()
#define PG8_SCHED __builtin_amdgcn_sched_barrier(0)
    Unit cur, nxt; int ui = 0;
    if (!S.next(0, cur)) return;
    Acc acc;
#pragma unroll
    for (int a = 0; a < 2; ++a)
#pragma unroll
        for (int b = 0; b < 2; ++b)
#pragma unroll
            for (int m = 0; m < 4; ++m)
#pragma unroll
                for (int n = 0; n < 2; ++n) acc[a][b][m][n] = (f32x4){0.f, 0.f, 0.f, 0.f};
    bf16x8 At[4][2], B0[2][2], B1[2][2];
    const char* cA = (const char*)g.A + (size_t)cur.pm * tstepA; const char* cB = (const char*)g.Bt + (size_t)cur.pn * tstepB;
    PG8_STAGE(PG8_SB(0, 0), cB, voffB); PG8_STAGE(PG8_SB(0, 1), cB + hstepB, voffB); PG8_STAGE(PG8_SA(0, 0), cA, voffA); PG8_STAGE(PG8_SA(0, 1), cA + hstepA, voffA);
    if (wr == 1) PG8_BAR;
    PG8_WAIT_V(2); PG8_BAR;
    PG8_STAGE(PG8_SB(1, 0), cB + kstep, voffB); PG8_STAGE(PG8_SA(1, 0), cA + kstep, voffA); PG8_STAGE(PG8_SB(1, 1), cB + hstepB + kstep, voffB);
    PG8_WAIT_V(6); PG8_BAR;
    for (;;) {
        const bool has_next = S.next(ui + 1, nxt);
        const char* nA = has_next ? (const char*)g.A + (size_t)nxt.pm * tstepA : cA; const char* nB = has_next ? (const char*)g.Bt + (size_t)nxt.pn * tstepB : cB;
        for (int t = 0; t < nt; t += 2) {
            if constexpr (Epi::MIDK) { if (t == (nt >> 1)) E.mid(acc, cur, wr, wc, fr, fq); }
            const bool last = (t == nt - 2);
            const char* a1 = cA + (size_t)(t + 1) * kstep;
            const char* a2 = last ? nA : cA + (size_t)(t + 2) * kstep; const char* b2 = last ? nB : cB + (size_t)(t + 2) * kstep;
            const char* a3 = a2 + kstep; const char* b3 = b2 + kstep;
            PG8_LDB(B0, 0, 0); PG8_LDB(B1, 0, 1); PG8_SCHED; PG8_LDA(At, 0, 0); PG8_STAGE(PG8_SA(1, 1), a1 + hstepA, voffA);
            PG8_WAIT_V(8); PG8_WAIT_L(0); PG8_BAR; PG8_MMA(0, 0, At, B0); PG8_MMA(0, 1, At, B1); PG8_BAR; PG8_SCHED;
            PG8_LDA(At, 0, 1); PG8_STAGE(PG8_SB(0, 0), b2, voffB); PG8_STAGE(PG8_SB(0, 1), b2 + hstepB, voffB); PG8_STAGE(PG8_SA(0, 0), a2, voffA);
            PG8_WAIT_V(8); PG8_WAIT_L(0); PG8_BAR; PG8_MMA(1, 0, At, B0); PG8_MMA(1, 1, At, B1); PG8_BAR; PG8_SCHED;
            PG8_LDB(B0, 1, 0); PG8_LDB(B1, 1, 1); PG8_SCHED; PG8_LDA(At, 1, 0); PG8_STAGE(PG8_SA(0, 1), a2 + hstepA, voffA);
            PG8_WAIT_V(8); PG8_WAIT_L(0); PG8_BAR; PG8_MMA(0, 0, At, B0); PG8_MMA(0, 1, At, B1); PG8_BAR; PG8_SCHED;
            PG8_LDA(At, 1, 1); PG8_STAGE(PG8_SB(1, 0), b3, voffB); PG8_STAGE(PG8_SB(1, 1), b3 + hstepB, voffB); PG8_STAGE(PG8_SA(1, 0), a3, voffA);
            PG8_WAIT_V(8); PG8_WAIT_L(0); PG8_BAR; PG8_MMA(1, 0, At, B0); PG8_MMA(1, 1, At, B1); PG8_BAR; PG8_SCHED;
        }
        if constexpr (ALIGN_EPI) { if (wr == 0) PG8_BAR; }
        E(acc, cur, ui, wr, wc, fr, fq);
        if (!has_next) break;
#pragma unroll
        for (int a = 0; a < 2; ++a)
#pragma unroll
            for (int b = 0; b < 2; ++b)
#pragma unroll
                for (int m = 0; m < 4; ++m)
#pragma unroll
                    for (int n = 0; n < 2; ++n) acc[a][b][m][n] = (f32x4){0.f, 0.f, 0.f, 0.f};
        cur = nxt; cA = nA; cB = nB; ++ui;
        if constexpr (ALIGN_EPI) { if (wr == 1) PG8_BAR; }
    }
    PG8_WAIT_V(0);
    if constexpr (!ALIGN_EPI) { if (wr == 0) PG8_BAR; }
    PG8_BAR;
#undef PG8_SA
#undef PG8_SB
#undef PG8_STAGE
#undef PG8_LDA
#undef PG8_LDB
#undef PG8_MMA
#undef PG8_WAIT_V
#undef PG8_WAIT_L
#undef PG8_BAR
#undef PG8_SCHED
}

__device__ __forceinline__ u32x4 pack8(const f32x4 v0, const f32x4 v1) { u32x4 w; w.x = cvt_pk_bf16(v0[0], v0[1]); w.y = cvt_pk_bf16(v0[2], v0[3]); w.z = cvt_pk_bf16(v1[0], v1[1]); w.w = cvt_pk_bf16(v1[2], v1[3]); return w; }
__device__ __forceinline__ void unpack8(const u32x4 w, float (&f)[8]) { f[0] = bflo(w.x); f[1] = bfhi(w.x); f[2] = bflo(w.y); f[3] = bfhi(w.y); f[4] = bflo(w.z); f[5] = bfhi(w.z); f[6] = bflo(w.w); f[7] = bfhi(w.w); }
struct EpiP { static constexpr bool PERM = true, MIDK = false; bf16* P; const LAS float* rst; const LAS float* wtab; float* kmean; LAS float* red;
    __device__ __forceinline__ void operator()(Acc& acc, const Unit& u, int ui, int wr, int wc, int fr, int fq) const {
        const int row0 = u.pm * BM + wr * 64 + fr, col0 = u.pn * BM + wc * 32 + 8 * fq;
        if (u.pn >= 40) {
#pragma unroll
            for (int ai = 0; ai < 2; ++ai)
#pragma unroll
                for (int m = 0; m < 4; ++m) { const int rowl = ai * HALF + wr * 64 + m * 16 + fr; const float rs = rst[ui * 256 + rowl] * (-1.4426950408889634f);
                    unsigned char* rowp = (unsigned char*)(P + (size_t)(u.pm * BM + rowl) * INC + CGA) + (col0 - CGA);
#pragma unroll
                    for (int bj = 0; bj < 2; ++bj) { unsigned w[2];
#pragma unroll
                        for (int n = 0; n < 2; ++n) { unsigned q4 = 0;
#pragma unroll
                            for (int e = 0; e < 4; ++e) { const float sg = __builtin_amdgcn_rcpf(1.f + __builtin_amdgcn_exp2f(acc[ai][bj][m][n][e] * rs));
                                unsigned q = (unsigned)(sg * 255.f + 0.5f); q = q < 1u ? 1u : q; q4 |= q << (8 * e); }
                            w[n] = q4; }
                        v2u o = {w[0], w[1]}; *(v2u*)(rowp + bj * HALF) = o; } }
            return;
        }
        if (u.pn >= 16) {
#pragma unroll
            for (int ai = 0; ai < 2; ++ai)
#pragma unroll
                for (int m = 0; m < 4; ++m) { const int rowl = ai * HALF + wr * 64 + m * 16 + fr; const float rs = rst[ui * 256 + rowl]; bf16* rowp = P + (size_t)(u.pm * BM + rowl) * INC + col0;
#pragma unroll
                    for (int bj = 0; bj < 2; ++bj) *(u32x4*)(rowp + bj * HALF) = pack8(acc[ai][bj][m][0] * rs, acc[ai][bj][m][1] * rs); }
            return;
        }
        const bool isK = u.pn >= 8;
        asm volatile("" : "+v"(fr), "+v"(fq));
#pragma unroll
        for (int ai = 0; ai < 2; ++ai)
#pragma unroll
            for (int m = 0; m < 4; ++m) { const int rowl = ai * HALF + wr * 64 + m * 16 + fr; const float rs = rst[ui * 256 + rowl];
#pragma unroll
                for (int bj = 0; bj < 2; ++bj) { const f32x4 a = acc[ai][bj][m][0] * rs, b = acc[ai][bj][m][1] * rs;
                    float ss = ((a[0] * a[0] + a[1] * a[1]) + (a[2] * a[2] + a[3] * a[3])) + ((b[0] * b[0] + b[1] * b[1]) + (b[2] * b[2] + b[3] * b[3]));
                    ss += __shfl_xor(ss, 16); ss += __shfl_xor(ss, 32);
                    if (fq == 0) red[(rowl * 2 + bj) * 4 + wc] = ss; }
                __builtin_amdgcn_sched_barrier(0); }
        asm volatile("s_waitcnt lgkmcnt(0)" ::: "memory"); __builtin_amdgcn_s_barrier(); asm volatile("" ::: "memory");
        int pmv = u.pm, c0v = col0; asm volatile("" : "+v"(pmv), "+v"(c0v));
        const LAS float* wsrc = wtab + (isK ? 128 : 0) + wc * 32 + 8 * fq;
        const f32x4 w0 = *(const LAS f32x4*)wsrc, w1 = *(const LAS f32x4*)(wsrc + 4);
#pragma unroll
        for (int ai = 0; ai < 2; ++ai)
#pragma unroll
            for (int m = 0; m < 4; ++m) { int ro = ai * HALF + m * 16; asm volatile("" : "+v"(ro));
                const int rowl = ro + wr * 64 + fr; bf16* rowp = P + (size_t)(pmv * BM + rowl) * INC + c0v; const float rs = rst[ui * 256 + rowl];
#pragma unroll
                for (int bj = 0; bj < 2; ++bj) { const f32x4 t4 = *(const LAS f32x4*)(red + (rowl * 2 + bj) * 4);
                    const float tot = (t4[0] + t4[1]) + (t4[2] + t4[3]); const float rn = rs * __builtin_amdgcn_rsqf(tot * (1.f / HD) + EPS);
                    const f32x4 v0 = acc[ai][bj][m][0] * rn * w0, v1 = acc[ai][bj][m][1] * rn * w1;
                    *(u32x4*)(rowp + bj * HALF) = pack8(v0, v1); }
                __builtin_amdgcn_sched_barrier(0); }
        if (isK) {
            LAS float* csum = red + 2048;
            f32x4 cs[2][2];
#pragma unroll
            for (int bj = 0; bj < 2; ++bj) { cs[bj][0] = (f32x4){0.f, 0.f, 0.f, 0.f}; cs[bj][1] = (f32x4){0.f, 0.f, 0.f, 0.f}; }
#pragma unroll
            for (int ai = 0; ai < 2; ++ai)
#pragma unroll
                for (int m = 0; m < 4; ++m) { int ro = ai * HALF + m * 16; asm volatile("" : "+v"(ro));
                    const int rowl = ro + wr * 64 + fr; const float rs = rst[ui * 256 + rowl];
#pragma unroll
                    for (int bj = 0; bj < 2; ++bj) { const f32x4 t4 = *(const LAS f32x4*)(red + (rowl * 2 + bj) * 4);
                        const float tot = (t4[0] + t4[1]) + (t4[2] + t4[3]); const float rn = rs * __builtin_amdgcn_rsqf(tot * (1.f / HD) + EPS);
                        cs[bj][0] += acc[ai][bj][m][0] * rn * w0; cs[bj][1] += acc[ai][bj][m][1] * rn * w1; }
                    __builtin_amdgcn_sched_barrier(0); }
            float cv[16];
#pragma unroll
            for (int i = 0; i < 16; ++i) cv[i] = cs[i >> 3][(i >> 2) & 1][i & 3];
#pragma unroll
            for (int st = 0; st < 4; ++st) { const int half = 8 >> st; const bool bit = (fr & half) != 0;
#pragma unroll
                for (int i = 0; i < half; ++i) { const float keep = bit ? cv[i + half] : cv[i], send = bit ? cv[i] : cv[i + half]; cv[i] = keep + __shfl_xor(send, half); } }
            csum[wr * 256 + (fr >> 3) * HALF + wc * 32 + 8 * fq + (fr & 7)] = cv[0];
            asm volatile("s_waitcnt lgkmcnt(0)" ::: "memory"); __builtin_amdgcn_s_barrier(); asm volatile("" ::: "memory");
            const int tid = threadIdx.x;
            if (tid < 256) kmean[(((u.pn - 8) * 2 + (tid >> 7)) * NBLK + u.pm) * HD + (tid & 127)] = (csum[tid] + csum[256 + tid]) * (1.f / BLK);
        }
    }
};
struct EpiMrg { static constexpr bool PERM = true, MIDK = true; const bf16* P; bf16* mrg;
    __device__ __forceinline__ static void ub8(const v2u w, float (&f)[8]) {
#pragma unroll
        for (int e = 0; e < 4; ++e) { f[e] = (float)((w.x >> (8 * e)) & 255u); f[4 + e] = (float)((w.y >> (8 * e)) & 255u); } }
    __device__ __forceinline__ void mid(Acc& acc, const Unit& u, int wr, int wc, int fr, int fq) const {
        int row0 = u.pm * BM + wr * 64 + fr, col0 = u.pn * BM + wc * 32 + 8 * fq;
        asm volatile("" : "+v"(row0), "+v"(col0));
#pragma unroll
        for (int ai = 0; ai < 2; ++ai) { v2u ga[4][2], gl[4][2];
#pragma unroll
            for (int m = 0; m < 4; ++m) { const unsigned char* rowp = (const unsigned char*)(P + (size_t)(row0 + ai * HALF + m * 16) * INC + CGA) + col0;
#pragma unroll
                for (int bj = 0; bj < 2; ++bj) { ga[m][bj] = *(const v2u*)(rowp + bj * HALF); gl[m][bj] = *(const v2u*)(rowp + 2048 + bj * HALF); } }
#pragma unroll
            for (int m = 0; m < 4; ++m)
#pragma unroll
                for (int bj = 0; bj < 2; ++bj) { float a[8], l[8]; ub8(ga[m][bj], a); ub8(gl[m][bj], l);
#pragma unroll
                    for (int e = 0; e < 8; ++e) acc[ai][bj][m][e >> 2][e & 3] *= a[e] * __builtin_amdgcn_rcpf(l[e]); }
            asm volatile("" ::: "memory"); }
    }
    __device__ __forceinline__ void operator()(const Acc& acc, const Unit& u, int ui, int wr, int wc, int fr, int fq) const {
        const int row0 = u.pm * BM + wr * 64 + fr, col0 = u.pn * BM + wc * 32 + 8 * fq;
#pragma unroll
        for (int ai = 0; ai < 2; ++ai) { v2u gl[4][2];
#pragma unroll
            for (int m = 0; m < 4; ++m) { const unsigned char* rowp = (const unsigned char*)(P + (size_t)(row0 + ai * HALF + m * 16) * INC + CGA) + col0;
#pragma unroll
                for (int bj = 0; bj < 2; ++bj) gl[m][bj] = *(const v2u*)(rowp + 2048 + bj * HALF); }
#pragma unroll
            for (int m = 0; m < 4; ++m) { const int r = row0 + ai * HALF + m * 16;
#pragma unroll
                for (int bj = 0; bj < 2; ++bj) { float l[8]; ub8(gl[m][bj], l); f32x4 v0, v1;
#pragma unroll
                    for (int e = 0; e < 4; ++e) { v0[e] = acc[ai][bj][m][0][e] * (l[e] * (1.f / 255.f)); v1[e] = acc[ai][bj][m][1][e] * (l[4 + e] * (1.f / 255.f)); }
                    *(u32x4*)(mrg + (size_t)r * DM + col0 + bj * HALF) = pack8(v0, v1); } }
            asm volatile("" ::: "memory"); }
    }
};
struct EpiX1 { static constexpr bool PERM = true, MIDK = false; const bf16* xb; float* out; bf16* x1b; float* ssq;
    __device__ __forceinline__ void operator()(const Acc& acc, const Unit& u, int ui, int wr, int wc, int fr, int fq) const {
        asm volatile("" : "+v"(fr), "+v"(fq));
        const int row0 = u.pm * BM + wr * 64 + fr, col0 = u.pn * BM + wc * 32 + 8 * fq;
        u32x4 xv[2][4][2];
#pragma unroll
        for (int ai = 0; ai < 2; ++ai)
#pragma unroll
            for (int m = 0; m < 4; ++m) { const size_t off = (size_t)(row0 + ai * HALF + m * 16) * DM + col0;
#pragma unroll
                for (int bj = 0; bj < 2; ++bj) xv[ai][m][bj] = *(const u32x4*)(xb + off + bj * HALF); }
#pragma unroll
        for (int ai = 0; ai < 2; ++ai) {
#pragma unroll
            for (int m = 0; m < 4; ++m) { const int r = row0 + ai * HALF + m * 16; const size_t off = (size_t)r * DM + col0; float ss = 0.f;
#pragma unroll
                for (int bj = 0; bj < 2; ++bj) { const u32x4 w = xv[ai][m][bj];
                    const f32x4 x0 = {bflo(w.x), bfhi(w.x), bflo(w.y), bfhi(w.y)}, x1_ = {bflo(w.z), bfhi(w.z), bflo(w.w), bfhi(w.w)};
                    const f32x4 v0 = x0 + acc[ai][bj][m][0], v1 = x1_ + acc[ai][bj][m][1];
                    *(u32x4*)(x1b + off + bj * HALF) = pack8(v0, v1);
                    ss += ((v0[0] * v0[0] + v0[1] * v0[1]) + (v0[2] * v0[2] + v0[3] * v0[3])) + ((v1[0] * v1[0] + v1[1] * v1[1]) + (v1[2] * v1[2] + v1[3] * v1[3])); }
                ss += __shfl_xor(ss, 16); ss += __shfl_xor(ss, 32);
                if (fq == 0) ssq[r * 32 + u.pn * 4 + wc] = ss; }
            asm volatile("" ::: "memory"); }
    }
};
struct EpiAct { static constexpr bool PERM = true, MIDK = false; const LAS float* rst; bf16* act; int pn_off;
    __device__ __forceinline__ void operator()(const Acc& acc, const Unit& u, int ui, int wr, int wc, int fr, int fq) const {
        const int col0 = (u.pn + pn_off) * HALF + wc * 32 + 8 * fq;
#pragma unroll
        for (int ai = 0; ai < 2; ++ai)
#pragma unroll
            for (int m = 0; m < 4; ++m) { const int rowl = ai * HALF + wr * 64 + m * 16 + fr; const float rs = rst[ui * 256 + rowl];
                f32x4 v0, v1;
#pragma unroll
                for (int e = 0; e < 4; ++e) { const float g0 = acc[ai][0][m][0][e] * rs, u0 = acc[ai][1][m][0][e] * rs, g1 = acc[ai][0][m][1][e] * rs, u1 = acc[ai][1][m][1][e] * rs;
                    v0[e] = g0 * __builtin_amdgcn_rcpf(1.f + __expf(-g0)) * u0; v1[e] = g1 * __builtin_amdgcn_rcpf(1.f + __expf(-g1)) * u1; }
                *(u32x4*)(act + (size_t)(u.pm * BM + rowl) * DFF + col0) = pack8(v0, v1); }
    }
};
struct EpiOut { static constexpr bool PERM = true, MIDK = false; const bf16* x1b; float* out;
    __device__ __forceinline__ void operator()(const Acc& acc, const Unit& u, int ui, int wr, int wc, int fr, int fq) const {
        const int row0 = u.pm * BM + wr * 64 + fr, col0 = u.pn * BM + wc * 32 + 8 * fq;
        u32x4 xv[2][4][2];
#pragma unroll
        for (int ai = 0; ai < 2; ++ai)
#pragma unroll
            for (int m = 0; m < 4; ++m) { const size_t off = (size_t)(row0 + ai * HALF + m * 16) * DM + col0;
#pragma unroll
                for (int bj = 0; bj < 2; ++bj) xv[ai][m][bj] = *(const u32x4*)(x1b + off + bj * HALF); }
#pragma unroll
        for (int ai = 0; ai < 2; ++ai) {
#pragma unroll
            for (int m = 0; m < 4; ++m) { const size_t off = (size_t)(row0 + ai * HALF + m * 16) * DM + col0;
#pragma unroll
                for (int bj = 0; bj < 2; ++bj) { const u32x4 w = xv[ai][m][bj];
                    const f32x4 r0 = {bflo(w.x), bfhi(w.x), bflo(w.y), bfhi(w.y)}, r1 = {bflo(w.z), bfhi(w.z), bflo(w.w), bfhi(w.w)};
                    *(f32x4*)(out + off + bj * HALF) = r0 + acc[ai][bj][m][0]; *(f32x4*)(out + off + bj * HALF + 4) = r1 + acc[ai][bj][m][1]; } }
            asm volatile("" ::: "memory"); }
    }
};
struct EpiNull { static constexpr bool PERM = true, MIDK = false;
    __device__ __forceinline__ void operator()(const Acc& acc, const Unit&, int, int, int, int, int) const {
#pragma unroll
        for (int ai = 0; ai < 2; ++ai)
#pragma unroll
            for (int bj = 0; bj < 2; ++bj)
#pragma unroll
                for (int m = 0; m < 4; ++m)
#pragma unroll
                    for (int n = 0; n < 2; ++n) asm volatile("" :: "v"(acc[ai][bj][m][n]));
    }
};
}


namespace att {
typedef short bf16x8 __attribute__((ext_vector_type(8)));
typedef short s16x4 __attribute__((ext_vector_type(4)));
typedef float f32x16 __attribute__((ext_vector_type(16)));
constexpr int KT = 16384;
constexpr int L_K = 0, L_V = 65536, L_WS = 131072, L_PREF = 131072 + 4096;
constexpr float LOG2E = 1.4426950408889634f;
constexpr float QSCALE = ATT_SCALE * LOG2E;
#define KSWZ(row, colB) ((row) * 256 + ((colB) ^ (((row) & 15) << 4)))
#define SBAR() __builtin_amdgcn_sched_barrier(0)
__device__ __forceinline__ int v_st(int k, int c) { const int kk = (k & ~0xC) | ((k & 4) << 1) | ((k & 8) >> 1); return ((kk >> 3) * 4 + (c >> 5)) * 512 + ((kk & 7) * 32 + (c & 31)) * 2; }
__device__ __forceinline__ int v_rd_base(int lane) { return ((lane & 3) << 3) | (((lane >> 2) & 3) << 6) | (((lane >> 4) & 1) << 5) | (((lane >> 5) & 1) << 8); }
__device__ __forceinline__ int crow(int r, int hi) { return (r & 3) + 8 * (r >> 2) + 4 * hi; }
__device__ __forceinline__ unsigned cvtpk(float lo, float hi) { unsigned r; asm volatile("v_cvt_pk_bf16_f32 %0, %1, %2" : "=v"(r) : "v"(lo), "v"(hi)); return r; }

__device__ __forceinline__ void stage_kv(LAS unsigned char* lds, const bf16* P, int j, int h, int tid) {
    const int sr = tid >> 4, sc = (tid & 15) * 8;
    const bf16* kb = P + (size_t)(j * BLK + sr) * INC + CK + h * HD + sc;
    const bf16* vb = P + (size_t)(j * BLK + sr) * INC + CV + h * HD + sc;
    v4u kr[8], vr[8];
#pragma unroll
    for (int i = 0; i < 8; ++i) { kr[i] = *(const v4u*)(kb + (size_t)(i * 32) * INC); vr[i] = *(const v4u*)(vb + (size_t)(i * 32) * INC); }
    const int kws = KSWZ(sr, sc * 2), vs0 = v_st(sr, sc), vs1 = v_st(32 + sr, sc);
#pragma unroll
    for (int i = 0; i < 8; ++i) { const int tile = i >> 1, half = i & 1;
        *(LAS v4u*)(lds + L_K + tile * KT + kws + half * 32 * 256) = kr[i];
        *(LAS v4u*)(lds + L_V + tile * KT + (half ? vs1 : vs0)) = vr[i]; }
}
__device__ __forceinline__ void qkt(f32x16& p0, f32x16& p1, const LAS unsigned char* Kt, int r32, int hi, const bf16x8* qr) {
#define KLD(X0, X1, d0) do { const LAS unsigned char* a_ = Kt + KSWZ(r32, ((d0) * 16 + hi * 8) * 2); X0 = *(const LAS bf16x8*)a_; X1 = *(const LAS bf16x8*)(a_ + 32 * 256); } while (0)
    bf16x8 a0, a1, b0, b1;
    KLD(a0, a1, 0);
#pragma unroll
    for (int d0 = 0; d0 < 8; d0 += 2) {
        KLD(b0, b1, d0 + 1); SBAR();
        p0 = __builtin_amdgcn_mfma_f32_32x32x16_bf16(a0, qr[d0], p0, 0, 0, 0); p1 = __builtin_amdgcn_mfma_f32_32x32x16_bf16(a1, qr[d0], p1, 0, 0, 0); SBAR();
        if (d0 + 2 < 8) { KLD(a0, a1, d0 + 2); SBAR(); }
        p0 = __builtin_amdgcn_mfma_f32_32x32x16_bf16(b0, qr[d0 + 1], p0, 0, 0, 0); p1 = __builtin_amdgcn_mfma_f32_32x32x16_bf16(b1, qr[d0 + 1], p1, 0, 0, 0); SBAR();
    }
#undef KLD
}
__device__ __forceinline__ void pv_tile(f32x16* o, int vb, bf16x8 pa0, bf16x8 pa1, bf16x8 pa2, bf16x8 pa3) {
#define TRRD(dst, off) asm volatile("ds_read_b64_tr_b16 %0, %1 offset:%2" : "=&v"(dst) : "v"(vb), "i"(off) : "memory")
#define PV_RD(S, d0) do { constexpr int b_ = (d0) * 512; TRRD(S##l0, b_); TRRD(S##h0, b_ + 2048); TRRD(S##l1, b_ + 4096); TRRD(S##h1, b_ + 6144); TRRD(S##l2, b_ + 8192); TRRD(S##h2, b_ + 10240); TRRD(S##l3, b_ + 12288); TRRD(S##h3, b_ + 14336); } while (0)
#define PV_MM(S, d0) do { \
        o[d0] = __builtin_amdgcn_mfma_f32_32x32x16_bf16(pa0, (bf16x8){S##l0[0], S##l0[1], S##l0[2], S##l0[3], S##h0[0], S##h0[1], S##h0[2], S##h0[3]}, o[d0], 0, 0, 0); \
        o[d0] = __builtin_amdgcn_mfma_f32_32x32x16_bf16(pa1, (bf16x8){S##l1[0], S##l1[1], S##l1[2], S##l1[3], S##h1[0], S##h1[1], S##h1[2], S##h1[3]}, o[d0], 0, 0, 0); \
        o[d0] = __builtin_amdgcn_mfma_f32_32x32x16_bf16(pa2, (bf16x8){S##l2[0], S##l2[1], S##l2[2], S##l2[3], S##h2[0], S##h2[1], S##h2[2], S##h2[3]}, o[d0], 0, 0, 0); \
        o[d0] = __builtin_amdgcn_mfma_f32_32x32x16_bf16(pa3, (bf16x8){S##l3[0], S##l3[1], S##l3[2], S##l3[3], S##h3[0], S##h3[1], S##h3[2], S##h3[3]}, o[d0], 0, 0, 0); } while (0)
    s16x4 Al0, Al1, Al2, Al3, Ah0, Ah1, Ah2, Ah3, Bl0, Bl1, Bl2, Bl3, Bh0, Bh1, Bh2, Bh3;
    PV_RD(A, 0); PV_RD(B, 1);
    asm volatile("s_waitcnt lgkmcnt(8)" ::: "memory"); SBAR(); PV_MM(A, 0); SBAR();
    PV_RD(A, 2);
    asm volatile("s_waitcnt lgkmcnt(8)" ::: "memory"); SBAR(); PV_MM(B, 1); SBAR();
    PV_RD(B, 3);
    asm volatile("s_waitcnt lgkmcnt(8)" ::: "memory"); SBAR(); PV_MM(A, 2); SBAR();
    asm volatile("s_waitcnt lgkmcnt(0)" ::: "memory"); SBAR(); PV_MM(B, 3);
#undef PV_MM
#undef PV_RD
#undef TRRD
}
__device__ __forceinline__ void softmax_tile(f32x16& p0, f32x16& p1, float& l_reg, bf16x8& pa0, bf16x8& pa1, bf16x8& pa2, bf16x8& pa3) {
#pragma unroll
    for (int r = 0; r < 16; ++r) { p0[r] = __builtin_amdgcn_exp2f(p0[r]); p1[r] = __builtin_amdgcn_exp2f(p1[r]); }
    float ps = 0.f;
#pragma unroll
    for (int r = 0; r < 16; ++r) ps += p0[r];
#pragma unroll
    for (int r = 0; r < 16; ++r) ps += p1[r];
    l_reg += ps;
#define PK4(Pv, B_, OUT) do { unsigned a0 = cvtpk(Pv[B_ + 0], Pv[B_ + 1]), a1 = cvtpk(Pv[B_ + 2], Pv[B_ + 3]); \
        unsigned b0 = cvtpk(Pv[B_ + 4], Pv[B_ + 5]), b1 = cvtpk(Pv[B_ + 6], Pv[B_ + 7]); \
        auto r0 = __builtin_amdgcn_permlane32_swap(a0, b0, false, false); auto r1 = __builtin_amdgcn_permlane32_swap(a1, b1, false, false); \
        v4u w = {r0[0], r1[0], r0[1], r1[1]}; OUT = __builtin_bit_cast(bf16x8, w); } while (0)
    PK4(p0, 0, pa0); PK4(p0, 8, pa1); PK4(p1, 0, pa2); PK4(p1, 8, pa3);
#undef PK4
}
__device__ __forceinline__ void init_bias(f32x16& p0, f32x16& p1, int kbase, int tile, int tq, float sl2, float ref, int hi) {
    const float base = sl2 * (float)(kbase + tile * 64 + 4 * hi - tq) - ref;
#pragma unroll
    for (int r = 0; r < 16; ++r) { const float c = base + sl2 * (float)((r & 3) + 8 * (r >> 2)); p0[r] = c; p1[r] = c + 32.f * sl2; }
}
__device__ __forceinline__ void mask_diag(f32x16& p0, f32x16& p1, int tile, int qloc, int hi) {
    const int dq = qloc - tile * 64 - 4 * hi; const float NEG = -__builtin_inff();
#pragma unroll
    for (int r = 0; r < 16; ++r) { const int c = (r & 3) + 8 * (r >> 2); if (dq - c < 0) p0[r] = NEG; if (dq - c - 32 < 0) p1[r] = NEG; }
}
__device__ __forceinline__ void block_pass(const bool MASKLAST, int ntile, const LAS unsigned char* lds, int vb0, bf16x8* qr, const bf16* nextq, int e_next, int kbase, int tq, float sl2, float ref, int r32, int hi, int qloc,
                                           float& l_reg, f32x16* o, int var = 0) {
#pragma unroll 1
    for (int tile = 0; tile < ntile; ++tile) {
        f32x16 p0, p1; bf16x8 pa0 = {}, pa1 = {}, pa2 = {}, pa3 = {};
        init_bias(p0, p1, kbase, tile, tq, sl2, ref, hi); if (!(var & 32)) qkt(p0, p1, lds + L_K + tile * KT, r32, hi, qr);
        if (nextq && tile + 1 == ntile) {
            const bf16* nq_ = nextq + (size_t)(e_next & 255) * INC;
#pragma unroll
            for (int d0 = 0; d0 < 8; ++d0) qr[d0] = *(const bf16x8*)(nq_ + d0 * 16); }
        if (MASKLAST && tile + 1 == ntile) mask_diag(p0, p1, tile, qloc, hi);
        if (!(var & 16)) softmax_tile(p0, p1, l_reg, pa0, pa1, pa2, pa3);
        SBAR();
        if (!(var & 8)) pv_tile(o, vb0 + tile * KT, pa0, pa1, pa2, pa3);
    }
}
__device__ __forceinline__ float att_ref(const float* qw, const float* kw, int lane) {
    float a = fmaxf(fabsf(qw[lane]), fabsf(qw[lane + 64])), b = fmaxf(fabsf(kw[lane]), fabsf(kw[lane + 64]));
#pragma unroll
    for (int o_ = 1; o_ < 64; o_ <<= 1) { a = fmaxf(a, __shfl_xor(a, o_)); b = fmaxf(b, __shfl_xor(b, o_)); }
    return fmaxf(0.f, 128.f * a * b * QSCALE - 64.f);
}
constexpr float ATT_SKEW = 0.15f;
constexpr int ATT_SC = 4, ATT_CC = 10;
}

__device__ __forceinline__ void phase_attp(const Ctx& C) {
    using namespace att;
    const bf16* P = (const bf16*)(C.ws + WS_P); const int* CNT = (const int*)(C.ws + WS_CNT); const unsigned short* LIST = (const unsigned short*)(C.ws + WS_LIST);
    float* ML = (float*)(C.ws + WS_ML);
    const int lane = C.lane, r32 = lane & 31, hi = lane >> 5, wid = C.wave;
    LAS float* wsf = (LAS float*)(C.lds + L_WS) + wid * 128; LAS int* rd_l = (LAS int*)(wsf + 64);
    LAS unsigned char* ost = C.lds + 143360 + wid * 2048;
    const float ref = C.ref;
    LAS int* pref = (LAS int*)(C.lds + L_PREF);
    LAS int* segp = (LAS int*)(C.lds + L_PREF + 256);
    LAS int* wsum = (LAS int*)(C.lds + L_PREF + 256 + 2064);
    const int vb0 = (int)(uintptr_t)(C.lds + L_V) + v_rd_base(lane);
    constexpr int NSEG = NBLK * NH;
    if (__builtin_amdgcn_readfirstlane(threadIdx.x) >= 256) __builtin_amdgcn_s_setprio(1);
    __syncthreads();
    {
        int cst = 0;
        if (C.tid < NSEG) { const int j = C.tid >> 4, h = C.tid & 15; const int* cp = CNT + (h * NBLK + j) * NBLK; int n = 0;
            typedef int i32x4 __attribute__((ext_vector_type(4))); i32x4 cv[8];
#pragma unroll
            for (int q4 = 0; q4 < 8; ++q4) cv[q4] = ((const i32x4*)cp)[q4];
#pragma unroll
            for (int q4 = 0; q4 < 8; ++q4)
#pragma unroll
                for (int e = 0; e < 4; ++e) n += (q4 * 4 + e > j) ? cv[q4][e] : 0;
            cst = ATT_SC + ATT_CC * ((n + BLK - 1) / BLK + 1); }
        int v = cst;
#pragma unroll
        for (int o_ = 1; o_ < 64; o_ <<= 1) { const int u_ = __shfl_up(v, o_); if (lane >= o_) v += u_; }
        if (lane == 63) wsum[wid] = v;
        __syncthreads();
        int add = 0;
#pragma unroll
        for (int w_ = 0; w_ < 8; ++w_) add += (w_ < wid) ? wsum[w_] : 0;
        if (C.tid < NSEG) segp[C.tid + 1] = v + add; if (C.tid == 0) segp[0] = 0;
        __syncthreads();
    }
    const long W = segp[NSEG];
    auto Fc = [&](int x) -> int { const float u = (float)x / (float)C.G; const float f = u + ATT_SKEW * u * (u - 1.f) * 0.5f; int v = (int)((float)W * f + 0.5f); return x >= C.G ? (int)W : (x <= 0 ? 0 : v); };
    const int clo = Fc(C.vcu), chi = Fc(C.vcu + 1);
    int t_first;
    { const bool below = C.tid < NSEG && segp[C.tid + 1] <= clo; const int cnt = __popcll(__ballot(below));
      if (lane == 0) wsum[8 + wid] = cnt;
      __syncthreads();
      t_first = 0;
#pragma unroll
      for (int w_ = 0; w_ < 8; ++w_) t_first += wsum[8 + w_]; }
    for (int t = t_first; t < NSEG; ++t) {
        const int s0 = segp[t]; if (s0 >= chi) break;
        const int s1 = segp[t + 1];
        if (s1 <= clo || s1 == s0) continue;
        const int k = (s1 - s0 - ATT_SC) / ATT_CC, kg = k - 1;
        int c_lo = 0; if (clo > s0) { c_lo = (clo - s0 - ATT_SC + ATT_CC - 1) / ATT_CC; if (c_lo < 1) c_lo = 1; }
        int c_hi = k; if (chi < s1) { c_hi = (chi > s0) ? ((chi - s0 - ATT_SC + ATT_CC - 1) / ATT_CC) : 0; if (chi > s0 && c_hi < 1) c_hi = 1; if (c_hi > k) c_hi = k; }
        if (c_hi <= c_lo) continue;
        const int j = t >> 4, h = t & 15;
        __syncthreads();
        if (C.tid < 64) { int c = (lane > j && lane < NBLK) ? CNT[(h * NBLK + j) * NBLK + lane] : 0;
#pragma unroll
            for (int o_ = 1; o_ < 64; o_ <<= 1) { const int v = __shfl_up(c, o_); if (lane >= o_) c += v; }
            if (lane < NBLK) pref[lane + 1] = c; if (lane == 0) pref[0] = 0; }
        if (!(C.var & 64)) stage_kv(C.lds, P, j, h, C.tid);
        __syncthreads();
        const float sl2 = exp2f(-0.5f * (float)(h + 1)) * LOG2E;
        const int n = pref[NBLK];
        const unsigned short* lst = LIST + (size_t)(h * NBLK + j) * NBLK * BLK;
#define ATT_LOOKUP(cc, OK, E, BS, VALID) do { if ((cc) == kg) { OK = true; VALID = true; BS = j; E = (wid * 32 + r32) | (3 << 8); break; } \
            const int rb_ = (int)((long)(cc) * n / kg), re_ = (int)((long)((cc) + 1) * n / kg); const int g0_ = rb_ + wid * 32; \
            OK = g0_ < re_; if (OK) { const int g_ = g0_ + r32; VALID = g_ < re_; const int gg_ = VALID ? g_ : g0_; int bs_ = j + 1; \
                { int lo_ = j + 1, hi_ = NBLK - 1; _Pragma("unroll") for (int it_ = 0; it_ < 5; ++it_) { const int mid_ = (lo_ + hi_ + 1) >> 1; const bool ge_ = gg_ >= pref[mid_]; lo_ = ge_ ? mid_ : lo_; hi_ = ge_ ? hi_ : mid_ - 1; } bs_ = lo_; } \
                E = lst[(size_t)bs_ * BLK + (gg_ - pref[bs_])]; BS = bs_; } } while (0)
        bool ok_c, valid = false; int e_c = 0, bs_c = 0;
        ATT_LOOKUP(c_lo, ok_c, e_c, bs_c, valid);
        const bf16* qbase = P + CQ + h * HD + hi * 8;
        bf16x8 qr[8];
        if (ok_c) { const bf16* q0 = qbase + (size_t)(bs_c * BLK + (e_c & 255)) * INC;
#pragma unroll
            for (int d0 = 0; d0 < 8; ++d0) qr[d0] = *(const bf16x8*)(q0 + d0 * 16); }
        for (int c = c_lo; c < c_hi; ++c) {
            bool ok_n = false, valid_n = false; int e_n = 0, bs_n = 0;
            if (c + 1 < c_hi) ATT_LOOKUP(c + 1, ok_n, e_n, bs_n, valid_n);
            const bf16* nqb = qbase + (size_t)(bs_n * BLK) * INC;
            if (ok_c) {
                const int tq = bs_c * BLK + (e_c & 255), slot = e_c >> 8;
                float l_reg = 0.f; f32x16 o[4] = {};
                const bool own = (c == kg);
                block_pass(own, own ? (wid >> 1) + 1 : 4, C.lds, vb0, qr, ok_n ? nqb : nullptr, e_n, j * BLK, tq, sl2, ref, r32, hi, wid * 32 + r32, l_reg, o, C.var);
                { auto rr = __builtin_amdgcn_permlane32_swap(__float_as_uint(l_reg), __float_as_uint(l_reg), false, false); l_reg = __uint_as_float(rr[0]) + __uint_as_float(rr[1]); }
                const int pidx = (tq * NH + h) * 3 + slot;
                const int drow = own ? (int)((WS_P + ((size_t)tq * INC + CXR + h * HD) * 2) >> 4) : (int)((WS_PO + (size_t)pidx * (HD * 2)) >> 4);
                if (hi == 0) { rd_l[r32] = (valid && !(C.var & 1)) ? drow : -1; if (valid && !(C.var & 1)) ML[(tq * NH + h) * 4 + slot] = l_reg; }
                asm volatile("s_waitcnt lgkmcnt(0)" ::: "memory");
#pragma unroll
                for (int d0 = 0; d0 < 4; ++d0) {
#pragma unroll
                    for (int r = 0; r < 16; ++r) *(LAS unsigned short*)(ost + crow(r, hi) * 64 + r32 * 2) = (unsigned short)cvtpk(o[d0][r], 0.f);
                    asm volatile("s_waitcnt lgkmcnt(0)" ::: "memory");
#pragma unroll
                    for (int i = 0; i < 2; ++i) { const int pc = lane + 64 * i, row = pc >> 2, chk = pc & 3; const int pd = rd_l[row]; const v4u vv = *(const LAS v4u*)(ost + row * 64 + chk * 16);
                        if (pd >= 0) *(v4u*)(C.ws + ((size_t)pd << 4) + (d0 * 32 + chk * 8) * 2) = vv; }
                    asm volatile("s_waitcnt lgkmcnt(0)" ::: "memory"); }
            } else if (ok_n) { const bf16* q0 = nqb + (size_t)(e_n & 255) * INC;
#pragma unroll
                for (int d0 = 0; d0 < 8; ++d0) qr[d0] = *(const bf16x8*)(q0 + d0 * 16); }
            ok_c = ok_n; e_c = e_n; bs_c = bs_n; valid = valid_n;
        }
#undef ATT_LOOKUP
    }
    __builtin_amdgcn_s_setprio(0);
}

struct AttoSel { int sj[2][2]; };
__device__ __forceinline__ void atto_presel(const Ctx& C, AttoSel& A) {
    const int* SELJ = (const int*)(C.ws + WS_SELJ);
#pragma unroll
    for (int it = 0; it < 2; ++it) { const int item = C.vcu + it * C.G; const int h = item & 15, b = (item >> 4) & (NBLK - 1);
#pragma unroll
        for (int pass = 0; pass < 2; ++pass) A.sj[it][pass] = SELJ[(b * BLK + C.wave * 32 + pass * 16 + (C.lane >> 2)) * NH + h]; }
}
__device__ __forceinline__ void phase_atto(const Ctx& C, const AttoSel& A) {
    using namespace att;
    const bf16* P = (const bf16*)(C.ws + WS_P); const bf16* PO = (const bf16*)(C.ws + WS_PO); const float* ML = (const float*)(C.ws + WS_ML); bf16* AL = (bf16*)(C.ws + WS_AL);
    const int lane = C.lane, wid = C.wave;
    const int* SELJ = (const int*)(C.ws + WS_SELJ); const float qkb = C.qkb;
    int it = 0;
    for (int item = C.vcu; item < NH * NBLK; item += C.G, ++it) {
        const int h = item & 15, b = item >> 4;
        const int nsel = b < 3 ? b : 3; const int ch = (lane & 3) * 8;
        v4u ow[2][4], pv8[2][3][4]; f32x4 lv[2]; int sjv[2];
#pragma unroll
        for (int pass = 0; pass < 2; ++pass) { const int trow = b * BLK + wid * 32 + pass * 16 + (lane >> 2);
            sjv[pass] = it == 0 ? A.sj[0][pass] : (it == 1 ? A.sj[1][pass] : SELJ[trow * NH + h]); }
#pragma unroll
        for (int pass = 0; pass < 2; ++pass) { const int trow = b * BLK + wid * 32 + pass * 16 + (lane >> 2); const int sjr = sjv[pass];
            lv[pass] = *(const f32x4*)(ML + (size_t)(trow * NH + h) * 4);
            const v4u* op = (const v4u*)(P + (size_t)trow * INC + CXR + h * HD + ch);
#pragma unroll
            for (int c8 = 0; c8 < 4; ++c8) ow[pass][c8] = op[c8 * 4];
#pragma unroll
            for (int s_ = 0; s_ < 3; ++s_) { const bool on = s_ < nsel && att_live(h, b - ((sjr >> (8 * s_)) & 255), qkb);
                const int pidx = (trow * NH + h) * 3 + s_;
                const v4u* po = (const v4u*)(PO + (size_t)(on ? pidx : (pidx & 1023)) * HD + ch);
#pragma unroll
                for (int c8 = 0; c8 < 4; ++c8) pv8[pass][s_][c8] = po[c8 * 4]; } }
#pragma unroll
        for (int pass = 0; pass < 2; ++pass) { const int trow = b * BLK + wid * 32 + pass * 16 + (lane >> 2); const int sjr = sjv[pass];
            float acc[32]; float den = lv[pass][3];
#pragma unroll
            for (int c8 = 0; c8 < 4; ++c8) { const unsigned w4[4] = {ow[pass][c8].x, ow[pass][c8].y, ow[pass][c8].z, ow[pass][c8].w};
#pragma unroll
                for (int e = 0; e < 4; ++e) { acc[c8 * 8 + 2 * e] = bflo(w4[e]); acc[c8 * 8 + 2 * e + 1] = bfhi(w4[e]); } }
#pragma unroll
            for (int s_ = 0; s_ < 3; ++s_) { const bool on = s_ < nsel && att_live(h, b - ((sjr >> (8 * s_)) & 255), qkb);
                den += on ? lv[pass][s_] : 0.f;
#pragma unroll
                for (int c8 = 0; c8 < 4; ++c8) { const unsigned w4[4] = {pv8[pass][s_][c8].x, pv8[pass][s_][c8].y, pv8[pass][s_][c8].z, pv8[pass][s_][c8].w};
#pragma unroll
                    for (int e = 0; e < 4; ++e) { acc[c8 * 8 + 2 * e] += on ? bflo(w4[e]) : 0.f; acc[c8 * 8 + 2 * e + 1] += on ? bfhi(w4[e]) : 0.f; } } }
            const float a0 = 1.0f / den;
            v4u* dst = (v4u*)(AL + (size_t)trow * 4096 + h * HD + ch);
#pragma unroll
            for (int c8 = 0; c8 < 4; ++c8) { v4u w; w.x = cvtpk(acc[c8 * 8] * a0, acc[c8 * 8 + 1] * a0); w.y = cvtpk(acc[c8 * 8 + 2] * a0, acc[c8 * 8 + 3] * a0); w.z = cvtpk(acc[c8 * 8 + 4] * a0, acc[c8 * 8 + 5] * a0); w.w = cvtpk(acc[c8 * 8 + 6] * a0, acc[c8 * 8 + 7] * a0); dst[c8 * 4] = w; } }
    }
}

#define XB_TMO      128
#define XB_XCNT(j)  (256  + 64 * (j))
#define XB_XSUB(j)  (1280 + 64 * (j))
#define XB_XGEN(j)  (2304 + 64 * (j))
#define XB_TOP      3328
#define XB_TOPGEN   3392
#define XCD_BAR_WORDS 3456
#define XB_SPIN_CAP (1u << 18)
__device__ __forceinline__ unsigned xb_ld(unsigned* p)              { return __hip_atomic_load(p, __ATOMIC_RELAXED, __HIP_MEMORY_SCOPE_AGENT); }
__device__ __forceinline__ unsigned xb_add(unsigned* p, unsigned v) { return __hip_atomic_fetch_add(p, v, __ATOMIC_RELAXED, __HIP_MEMORY_SCOPE_AGENT); }
__device__ __forceinline__ unsigned xb_xcc_id() { return (unsigned)__builtin_amdgcn_s_getreg((3 << 11) | 20) & 0xFu; }
#define XB_SPIN(cond, bar) do { unsigned _sp = 0; while (cond) { __builtin_amdgcn_s_sleep(1); \
    if ((++_sp & 255u) == 0u) { if (xb_ld(&(bar)[XB_TMO])) break; if (_sp > XB_SPIN_CAP) { atomicAdd(&(bar)[XB_TMO], 1u); break; } } } } while (0)
struct XcdBarrier { unsigned* bar; unsigned x; volatile LAS unsigned* st; };
__device__ __forceinline__ XcdBarrier xcd_barrier_post(unsigned* bar, volatile LAS unsigned* st) {
    XcdBarrier b; b.bar = bar; b.x = xb_xcc_id(); b.st = st;
    if (threadIdx.x == 0) (void)xb_add(&bar[XB_XCNT(b.x)], 1u);
    return b;
}
__device__ __forceinline__ void xcd_barrier_complete(unsigned* bar, unsigned x, unsigned& nloc, unsigned& nx) {
    const unsigned G = gridDim.x * gridDim.y * gridDim.z;
    unsigned sum, cnt, mine, sp = 0u;
    for (;;) {
        sum = 0u; cnt = 0u; mine = 0u;
#pragma unroll
        for (unsigned j = 0; j < 16; ++j) { const unsigned c = xb_ld(&bar[XB_XCNT(j)]); sum += c; cnt += (c > 0u) ? 1u : 0u; mine = (j == x) ? c : mine; }
        if (sum == G) break;
        __builtin_amdgcn_s_sleep(1);
        if ((++sp & 255u) == 0u) { if (xb_ld(&bar[XB_TMO])) break; if (sp > XB_SPIN_CAP) { atomicAdd(&bar[XB_TMO], 1u); break; } }
    }
    nloc = mine > 0u ? mine : 1u; nx = cnt > 0u ? cnt : 1u;
}
__device__ __forceinline__ void xcd_barrier(const XcdBarrier& b) {
    asm volatile("s_waitcnt vmcnt(0)" ::: "memory");
    __syncthreads();
    if (threadIdx.x == 0) {
        unsigned* bar = b.bar;
        __builtin_amdgcn_s_waitcnt(0);
        unsigned nloc = b.st[0], nx = b.st[1];
        if (nloc == 0u) { xcd_barrier_complete(bar, b.x, nloc, nx); b.st[0] = nloc; b.st[1] = nx; }
        const unsigned old = xb_add(&bar[XB_XSUB(b.x)], 1u);
        const unsigned gen = old / nloc;
        if (old + 1u == (gen + 1u) * nloc) {
            __builtin_amdgcn_fence(__ATOMIC_RELEASE, "agent");
            asm volatile("s_waitcnt vmcnt(0)" ::: "memory");
            const unsigned og = xb_add(&bar[XB_TOP], 1u);
            const unsigned tg = og / nx;
            if (og + 1u == (tg + 1u) * nx) xb_add(&bar[XB_TOPGEN], 1u);
            else XB_SPIN(xb_ld(&bar[XB_TOPGEN]) == tg, bar);
            __builtin_amdgcn_fence(__ATOMIC_ACQUIRE, "agent");
            xb_add(&bar[XB_XGEN(b.x)], 1u);
            asm volatile("s_waitcnt vmcnt(0)" ::: "memory");
        } else {
            XB_SPIN(xb_ld(&bar[XB_XGEN(b.x)]) == gen, bar);
            __builtin_amdgcn_fence(__ATOMIC_ACQUIRE, "agent");
            asm volatile("s_waitcnt vmcnt(0)" ::: "memory");
        }
    }
    __syncthreads();
}
constexpr int MISC_OFF = 163584;
constexpr int CW_BAR = 4096, CW_GU2 = 8192;
constexpr int RST_OFF = 131072 + 10240, WTAB_OFF = RST_OFF + 8 * 1024;

enum { PH_PREPA = 0, PH_GEMM1, PH_SEL_LRUA, PH_ATTP_LRUB, PH_ATTO, PH_PROJ, PH_OUT_PREPB, PH_UP, PH_DOWN, PH_N };
__global__ void __launch_bounds__(NTHR, 2) mk(Args args) {
    extern __shared__ __attribute__((aligned(16))) unsigned char lds_raw[];
    Ctx C; C.lds = (LAS unsigned char*)lds_raw; C.tid = threadIdx.x; C.lane = C.tid & 63; C.wave = __builtin_amdgcn_readfirstlane(C.tid >> 6);
    C.G = gridDim.x; { const int bx = blockIdx.x; C.vcu = (C.G % 8 == 0) ? (bx % 8) * (C.G / 8) + bx / 8 : bx; }
    C.in = args.in; C.out = args.out; C.ws = args.ws; C.var = args.var;
    {
        float a = 0.f, b = 0.f; const float* qw = C.in[I_QNW]; const float* kw = C.in[I_KNW];
#pragma unroll 16
        for (int i = 0; i < HD; ++i) { a = fmaxf(a, fabsf(qw[i])); b = fmaxf(b, fabsf(kw[i])); }
        C.qkb = 128.f * a * b * QSCALE_; C.ref = fmaxf(0.f, 128.f * a * b * QSCALE_ - 64.f); }
    const int lo = args.ph_lo, hi = args.ph_hi;
    volatile LAS unsigned* MISC = (volatile LAS unsigned*)(C.lds + MISC_OFF);
    if (C.tid < 32) MISC[C.tid] = 0u;
    __syncthreads();
    XcdBarrier bar; bar.bar = (unsigned*)(C.ws + WS_CTL) + CW_BAR; bar.x = 0; bar.st = nullptr;
    if (hi - lo > 1) bar = xcd_barrier_post((unsigned*)(C.ws + WS_CTL) + CW_BAR, MISC);
#define SEAM(k) do { if (IN(k) && IN((k) + 1)) xcd_barrier(bar); } while (0)
#ifndef PHMASK
#define PHMASK 0x1ff
#endif
#define IN(k) (((PHMASK >> (k)) & 1) && lo <= (k) && (k) < hi)
#define NREP(k) ((PROBE_REP == (k)) ? 2 : 1)
    if (IN(PH_PREPA)) for (int rep = 0; rep < NREP(PH_PREPA); ++rep) { phase_prepA(C); __syncthreads(); }
    SEAM(PH_PREPA);
    if (IN(PH_GEMM1)) { pg8::Gemm g{(const bf16*)(C.ws + WS_XB), (const bf16*)(C.ws + WS_WIN), DM, DM, S, NCOL, DM}; pg8::StaticOrder So; So.init(S, NCOL, C.G, (int)blockIdx.x);
        LAS float* rst = (LAS float*)(C.lds + RST_OFF); LAS float* wtab = (LAS float*)(C.lds + WTAB_OFF);
        { pg8::Unit uu; const float* R1 = (const float*)(C.ws + WS_RSTD1);
#pragma unroll
          for (int e = 0; e < 4; ++e) { const int idx = C.tid + e * NTHR, i = idx >> 8; const bool ok = So.next(i, uu); const float v = R1[(ok ? uu.pm : 0) * 256 + (idx & 255)]; if (ok) rst[idx] = v; }
          if (C.tid < 128) wtab[C.tid] = C.in[I_QNW][C.tid] * QSCALE_; else if (C.tid < 256) wtab[C.tid] = C.in[I_KNW][C.tid - 128];
          __syncthreads(); }
        pg8::EpiP E{(bf16*)(C.ws + WS_P), rst, wtab, (float*)(C.ws + WS_KMEAN), (LAS float*)(C.lds + 131072)}; pg8::gemm_phase<pg8::EpiP, true>(C.lds, g, So, E); }
    SEAM(PH_GEMM1);
    if (IN(PH_SEL_LRUA)) { for (int rep = 0; rep < NREP(PH_SEL_LRUA); ++rep) { phase_select(C); __syncthreads(); } for (int rep = 0; rep < NREP(10); ++rep) { LruPar lpar; if (C.vcu < 256) lru_par_load(C, C.vcu, lpar); phase_lru_a(C, lpar); __syncthreads(); } }
    SEAM(PH_SEL_LRUA);
    if (IN(PH_ATTP_LRUB)) { if (!(C.var & 2)) { phase_lru_b(C); __syncthreads(); } for (int rep = 0; rep < NREP(PH_ATTP_LRUB); ++rep) { if (!(C.var & 4)) phase_attp(C); __syncthreads(); } }
    AttoSel asel; if (IN(PH_ATTO)) atto_presel(C, asel);
    SEAM(PH_ATTP_LRUB);
    if (IN(PH_ATTO)) for (int rep = 0; rep < NREP(PH_ATTO); ++rep) { phase_atto(C, asel); __syncthreads(); }
    SEAM(PH_ATTO);
    if (IN(PH_PROJ)) { pg8::Gemm g{(const bf16*)(C.ws + WS_AL), (const bf16*)(C.ws + WS_WP), 2 * DM, 2 * DM, S, DM, 2 * DM}; pg8::StaticOrder So; So.init(S, DM, C.G, (int)blockIdx.x);
        pg8::EpiMrg E{(const bf16*)(C.ws + WS_P), (bf16*)(C.ws + WS_MRG)}; pg8::gemm_phase<pg8::EpiMrg, false>(C.lds, g, So, E); }
    SEAM(PH_PROJ);
    if (IN(PH_OUT_PREPB)) { pg8::Gemm g{(const bf16*)(C.ws + WS_MRG), (const bf16*)(C.ws + WS_WO), DM, DM, S, DM, DM}; pg8::StaticOrder So; So.init(S, DM, C.G, (int)blockIdx.x);
        pg8::EpiX1 E{(const bf16*)(C.ws + WS_XB), C.out, (bf16*)(C.ws + WS_X1B), (float*)(C.ws + WS_SSQ)}; pg8::gemm_phase<pg8::EpiX1, false>(C.lds, g, So, E);
        for (int rep = 0; rep < NREP(PH_OUT_PREPB); ++rep) { __syncthreads(); phase_prepB_gu(C, 0, C.vcu, C.G); } }
    SEAM(PH_OUT_PREPB);
    if (IN(PH_UP)) {
        const int nwgh = (S / 256) * (DFF / 256), fullh = nwgh / C.G, remh = nwgh - fullh * C.G; const int nX = remh ? C.G - remh : C.G;
        const int shift = (nX % 8 == 0 && remh) ? nX : 0; const int c1 = (int)blockIdx.x, c2 = (c1 + shift) % C.G;
        unsigned* gu2 = (unsigned*)(C.ws + WS_CTL) + CW_GU2;
        LAS float* rst = (LAS float*)(C.lds + RST_OFF);
        auto up_half = [&](const int hf) {
            pg8::Gemm g{(const bf16*)(C.ws + WS_X1B), (const bf16*)(C.ws + WS_WGU) + (size_t)hf * DFF * DM, DM, DM, S, DFF, DM}; pg8::StaticOrder So; So.init(S, DFF, C.G, hf ? c2 : c1);
            { pg8::Unit uu; const float* SSQ = (const float*)(C.ws + WS_SSQ);
              __syncthreads();
              int tl = C.tid; asm volatile("" : "+v"(tl));
              f32x4 sv[4][8]; bool okv[4];
#pragma unroll
              for (int e = 0; e < 4; ++e) { const int idx = tl + e * NTHR, i = idx >> 8; okv[e] = So.next(i, uu); const f32x4* sp = (const f32x4*)(SSQ + (size_t)((okv[e] ? uu.pm : 0) * 256 + (idx & 255)) * 32);
#pragma unroll
                  for (int k = 0; k < 8; ++k) sv[e][k] = sp[k]; }
#pragma unroll
              for (int e = 0; e < 4; ++e) { float s = 0.f;
#pragma unroll
                  for (int k = 0; k < 8; ++k) s += (sv[e][k][0] + sv[e][k][1]) + (sv[e][k][2] + sv[e][k][3]);
                  if (okv[e]) rst[tl + e * NTHR] = __builtin_amdgcn_rsqf(s * (1.f / DM) + EPS); }
              __syncthreads(); }
            pg8::EpiAct E{rst, (bf16*)(C.ws + WS_ACT), hf * (DFF / 256)}; pg8::gemm_phase<pg8::EpiAct, true>(C.lds, g, So, E);
            __syncthreads();
            if (hf == 0) {
                if (remh == 0 || c1 >= remh) {
                    phase_prepB_gu(C, 1, remh ? c1 - remh : c1, nX);
                    asm volatile("s_waitcnt vmcnt(0)" ::: "memory"); __syncthreads();
                    if (C.tid == 0) { __builtin_amdgcn_fence(__ATOMIC_RELEASE, "agent"); asm volatile("s_waitcnt vmcnt(0)" ::: "memory"); (void)xb_add(gu2, 1u); } }
                if (C.tid == 0) { unsigned* bar = (unsigned*)(C.ws + WS_CTL) + CW_BAR;
                    XB_SPIN(xb_ld(gu2) < (unsigned)nX, bar);
                    __builtin_amdgcn_fence(__ATOMIC_ACQUIRE, "agent"); asm volatile("s_waitcnt vmcnt(0)" ::: "memory"); }
                __syncthreads();
            } else {
                if (remh == 0) phase_prepB_d(C, c1, C.G); else if (c2 >= remh) phase_prepB_d(C, c2 - remh, C.G - remh); }
        };
        up_half(0); up_half(1); }
    SEAM(PH_UP);
    if (IN(PH_DOWN)) { pg8::Gemm g{(const bf16*)(C.ws + WS_ACT), (const bf16*)(C.ws + WS_WD), DFF, DFF, S, DM, DFF}; pg8::StaticOrder So; So.init(S, DM, C.G, (int)blockIdx.x);
        pg8::EpiOut E{(const bf16*)(C.ws + WS_X1B), C.out}; pg8::gemm_phase<pg8::EpiOut, false>(C.lds, g, So, E); }
#if PROBE_REP == 200
    if (lo == PH_N + 0) { pg8::Gemm g{(const bf16*)(C.ws + WS_X1B), (const bf16*)(C.ws + WS_WGU), DM, DM, S, 2 * DFF, DM}; pg8::StaticOrder So; So.init(S, 2 * DFF, C.G, (int)blockIdx.x);
        pg8::EpiNull E{}; pg8::gemm_phase<pg8::EpiNull, true>(C.lds, g, So, E); }
#elif PROBE_REP == 204
    if (lo == PH_N + 4) { pg8::Gemm g{(const bf16*)(C.ws + WS_XB), (const bf16*)(C.ws + WS_WIN), DM, DM, S, NCOL, DM}; pg8::StaticOrder So; So.init(S, NCOL, C.G, (int)blockIdx.x);
        pg8::EpiNull E{}; pg8::gemm_phase<pg8::EpiNull, true>(C.lds, g, So, E); }
#elif PROBE_REP == 201
    if (lo == PH_N + 1) { pg8::Gemm g{(const bf16*)(C.ws + WS_ACT), (const bf16*)(C.ws + WS_WD), DFF, DFF, S, DM, DFF}; pg8::StaticOrder So; So.init(S, DM, C.G, (int)blockIdx.x);
        pg8::EpiNull E{}; pg8::gemm_phase<pg8::EpiNull, false>(C.lds, g, So, E); }
#elif PROBE_REP == 202
    if (lo == PH_N + 2) { pg8::Gemm g{(const bf16*)(C.ws + WS_MRG), (const bf16*)(C.ws + WS_WO), DM, DM, S, DM, DM}; pg8::StaticOrder So; So.init(S, DM, C.G, (int)blockIdx.x);
        pg8::EpiX1 E{(const bf16*)(C.ws + WS_XB), (float*)(C.ws + WS_PO), (bf16*)(C.ws + WS_PO + 64 * MiB), (float*)(C.ws + WS_ML)}; pg8::gemm_phase<pg8::EpiX1, false>(C.lds, g, So, E); }
#elif PROBE_REP == 203
    if (lo == PH_N + 3) { pg8::Gemm g{(const bf16*)(C.ws + WS_ACT), (const bf16*)(C.ws + WS_WD), DFF, DFF, S, DM, DFF}; pg8::StaticOrder So; So.init(S, DM, C.G, (int)blockIdx.x);
        pg8::EpiOut E{(const bf16*)(C.ws + WS_X1B), (float*)(C.ws + WS_PO)}; pg8::gemm_phase<pg8::EpiOut, false>(C.lds, g, So, E); }
#endif
#undef IN
#undef SEAM
}

template <class Epi, bool MAPGU>
__global__ void __launch_bounds__(256) naive_gemm(const bf16* A0, const bf16* A1, int lda, const bf16* B0, const bf16* B1, int ldb, int K0, int K1, Epi epi) {
    __shared__ float As[32][68]; __shared__ float Bs[32][68];
    const int tid = threadIdx.x, tx = tid & 15, ty = tid >> 4;
    const int r0 = blockIdx.y * 64, n0 = blockIdx.x * 64;
    const size_t brow0 = MAPGU ? (size_t)(n0 >> 7) * 256 + (n0 & 127) : (size_t)n0;
    float acc[2][4][4];
#pragma unroll
    for (int p = 0; p < 2; ++p)
#pragma unroll
        for (int i = 0; i < 4; ++i)
#pragma unroll
            for (int j = 0; j < 4; ++j) acc[p][i][j] = 0.f;
    const int lr = tid >> 2, lk = (tid & 3) * 8;
#pragma unroll
    for (int p = 0; p < 2; ++p) {
        const bf16* A = p ? A1 : A0; const bf16* B = p ? B1 : B0; const int K = p ? K1 : K0;
        for (int k0 = 0; k0 < K; k0 += 32) {
            const v4u av = *(const v4u*)(A + (size_t)(r0 + lr) * lda + k0 + lk);
            const v4u bv = *(const v4u*)(B + (brow0 + lr) * (size_t)ldb + k0 + lk);
            __syncthreads();
            As[lk + 0][lr] = bflo(av.x); As[lk + 1][lr] = bfhi(av.x); As[lk + 2][lr] = bflo(av.y); As[lk + 3][lr] = bfhi(av.y);
            As[lk + 4][lr] = bflo(av.z); As[lk + 5][lr] = bfhi(av.z); As[lk + 6][lr] = bflo(av.w); As[lk + 7][lr] = bfhi(av.w);
            Bs[lk + 0][lr] = bflo(bv.x); Bs[lk + 1][lr] = bfhi(bv.x); Bs[lk + 2][lr] = bflo(bv.y); Bs[lk + 3][lr] = bfhi(bv.y);
            Bs[lk + 4][lr] = bflo(bv.z); Bs[lk + 5][lr] = bfhi(bv.z); Bs[lk + 6][lr] = bflo(bv.w); Bs[lk + 7][lr] = bfhi(bv.w);
            __syncthreads();
#pragma unroll 8
            for (int k = 0; k < 32; ++k) { const f32x4 a = *(const f32x4*)&As[k][ty * 4], b = *(const f32x4*)&Bs[k][tx * 4];
#pragma unroll
                for (int i = 0; i < 4; ++i)
#pragma unroll
                    for (int j = 0; j < 4; ++j) acc[p][i][j] += a[i] * b[j]; }
        }
    }
#pragma unroll
    for (int i = 0; i < 4; ++i)
#pragma unroll
        for (int j = 0; j < 4; ++j) epi(r0 + ty * 4 + i, n0 + tx * 4 + j, acc[0][i][j], acc[1][i][j]);
}
struct NE1 { const float* rstd1; bf16* P; __device__ void operator()(int r, int c, float a0, float) const { P[(size_t)r * INC + c] = (bf16)f2bf(a0 * rstd1[r]); } };
struct NE6 { const bf16* P; bf16* mrg; __device__ void operator()(int r, int c, float a0, float a1) const {
    const float ga = bf2f(P[(size_t)r * INC + CGA + c]), gl = bf2f(P[(size_t)r * INC + CGL + c]); mrg[(size_t)r * DM + c] = (bf16)f2bf(sigmoidf_(ga) * a0 + sigmoidf_(gl) * a1); } };
struct NE7 { const float* x; float* out; bf16* x1b; __device__ void operator()(int r, int c, float a0, float) const {
    const float v = x[(size_t)r * DM + c] + a0; out[(size_t)r * DM + c] = v; x1b[(size_t)r * DM + c] = (bf16)f2bf(v); } };
struct NE8 { const float* ssq; bf16* act; __device__ void operator()(int r, int c, float a0, float a1) const {
    float s = 0.f; for (int i = 0; i < 32; ++i) s += ssq[r * 32 + i]; const float rs = 1.0f / sqrtf(s * (1.f / DM) + EPS);
    const float g = a0 * rs, u = a1 * rs; act[(size_t)r * DFF + c] = (bf16)f2bf(g * sigmoidf_(g) * u); } };
struct NE9 { float* out; __device__ void operator()(int r, int c, float a0, float) const { out[(size_t)r * DM + c] += a0; } };

__global__ void __launch_bounds__(256) naive_rowssq(const float* x1, float* ssq) {
    const int row = blockIdx.x * 4 + (threadIdx.x >> 6), lane = threadIdx.x & 63;
    float s = 0.f; for (int i = lane; i < DM; i += 64) { const float v = x1[(size_t)row * DM + i]; s += v * v; }
    s = wave_sum(s); if (lane < 32) ssq[row * 32 + lane] = lane == 0 ? s : 0.f;
}

__global__ void __launch_bounds__(256) naive_attn(const bf16* P, const int* SELJ, bf16* AL) {
    __shared__ float qs[128]; __shared__ float sc[1024]; __shared__ float red[4]; __shared__ float part[2][128];
    const int tid = threadIdx.x, t = blockIdx.x >> 4, h = blockIdx.x & 15, b = t >> 8, nsel = b < 3 ? b : 3;
    const int sj = SELJ[t * NH + h];
    if (tid < 128) qs[tid] = bf2f(P[(size_t)t * INC + CQ + h * HD + tid]);
    __syncthreads();
    const float slope = exp2f(-0.5f * (float)(h + 1));
    float val[4]; float mx = -INFINITY;
#pragma unroll
    for (int s = 0; s < 4; ++s) {
        int key; bool ok;
        if (s < 3) { key = ((sj >> (8 * s)) & 255) * BLK + tid; ok = s < nsel; } else { key = b * BLK + tid; ok = key <= t; }
        float v = -INFINITY;
        if (ok) { const v4u* kr = (const v4u*)(P + (size_t)key * INC + CK + h * HD); float dsum = 0.f;
#pragma unroll
            for (int ch = 0; ch < 16; ++ch) { const v4u kv = kr[ch]; const int d = ch * 8;
                dsum += bflo(kv.x) * qs[d] + bfhi(kv.x) * qs[d + 1] + bflo(kv.y) * qs[d + 2] + bfhi(kv.y) * qs[d + 3]
                      + bflo(kv.z) * qs[d + 4] + bfhi(kv.z) * qs[d + 5] + bflo(kv.w) * qs[d + 6] + bfhi(kv.w) * qs[d + 7]; }
            v = dsum - slope * 1.4426950408889634f * (float)(t - key); }
        val[s] = v; mx = fmaxf(mx, v);
    }
#pragma unroll
    for (int o = 1; o < 64; o <<= 1) mx = fmaxf(mx, __shfl_xor(mx, o));
    if ((tid & 63) == 0) red[tid >> 6] = mx;
    __syncthreads();
    mx = fmaxf(fmaxf(red[0], red[1]), fmaxf(red[2], red[3]));
    __syncthreads();
    float ls = 0.f;
#pragma unroll
    for (int s = 0; s < 4; ++s) { const float p = (val[s] == -INFINITY) ? 0.f : exp2f(val[s] - mx); sc[s * 256 + tid] = p; ls += p; }
    ls = wave_sum(ls);
    if ((tid & 63) == 0) red[tid >> 6] = ls;
    __syncthreads();
    const float l = (red[0] + red[1]) + (red[2] + red[3]);
    const int d = tid & 127, half = tid >> 7; float acc = 0.f;
    for (int s = half * 2; s < half * 2 + 2; ++s) {
        const int base = (s < 3) ? ((sj >> (8 * s)) & 255) * BLK : b * BLK;
        if (s < 3 && s >= nsel) continue;
        for (int i = 0; i < 256; ++i) { const float p = sc[s * 256 + i]; if (p != 0.f) acc += p * bf2f(P[(size_t)(base + i) * INC + CV + h * HD + d]); }
    }
    part[half][d] = acc;
    __syncthreads();
    if (tid < 128) AL[(size_t)t * 4096 + h * HD + tid] = (bf16)f2bf((part[0][tid] + part[1][tid]) / l);
}

static void launch_mk(const Args& base, int lo, int hi, int grid, hipStream_t stream) {
    Args a = base; a.ph_lo = lo; a.ph_hi = hi;
    hipLaunchKernelGGL(mk, dim3(grid), dim3(NTHR), LDS_BYTES, stream, a);
}
extern "C" void kernel_launch(void* const* d_in, const int* in_sizes, int n_in, void* d_out, int out_size, void* d_ws, size_t ws_size, hipStream_t stream) {
    static int grid = 0;
    if (grid == 0) {
        if (n_in != 19 || in_sizes[0] != S * DM || out_size != S * DM || ws_size < WS_END) { fprintf(stderr, "kernel_launch: unexpected shapes (n_in %d, in0 %d, out %d, ws %zu)\n", n_in, n_in > 0 ? in_sizes[0] : -1, out_size, ws_size); grid = -1; return; }
        int dev = 0, cus = 0, per_cu = 0;
        if (hipGetDevice(&dev) != hipSuccess || hipDeviceGetAttribute(&cus, hipDeviceAttributeMultiprocessorCount, dev) != hipSuccess) { grid = -1; return; }
        if (hipFuncSetAttribute((const void*)mk, hipFuncAttributeMaxDynamicSharedMemorySize, LDS_BYTES) != hipSuccess) { fprintf(stderr, "kernel_launch: hipFuncSetAttribute failed\n"); grid = -1; return; }
        if (hipOccupancyMaxActiveBlocksPerMultiprocessor(&per_cu, (const void*)mk, NTHR, LDS_BYTES) != hipSuccess || per_cu < 1) fprintf(stderr, "kernel_launch: occupancy query says %d\n", per_cu);
        (void)hipGetLastError();
        grid = cus;
    }
    if (grid < 0) return;
    unsigned char* ws = (unsigned char*)d_ws;
    Args a{}; for (int i = 0; i < 19; ++i) a.in[i] = (const float*)d_in[i]; a.out = (float*)d_out; a.ws = ws;
#if defined(MK_PER_PHASE)
    for (int ph = 0; ph < PH_N; ++ph) launch_mk(a, ph, ph + 1, grid, stream);
#else
    if (hipMemsetAsync(ws + WS_CTL, 0, 65536, stream) != hipSuccess) { fprintf(stderr, "kernel_launch: memset failed\n"); return; }
    launch_mk(a, 0, PH_N, grid, stream);
#if PROBE_REP >= 200
    launch_mk(a, PH_N + PROBE_REP - 200, PH_N + PROBE_REP - 200 + 1, grid, stream);
#elif PROBE_REP >= 100
    { Args a2 = a; a2.var = PROBE_VAR; launch_mk(a2, PROBE_REP - 100, PROBE_REP - 100 + 1, grid, stream); }
#endif
#endif
}
```
